# Optimizing an MI355X kernel written in HIP

```python
import jax, jax.numpy as jnp
from jax import lax
import numpy as np

D_MODEL = 2048
BATCH = 8
SEQ = 4096
DEPTH = 4

CTX_LEN = 256
GRID_W = 64
N_MIXERS = 4
D_FF = 5632
DN_ALPHA = (2.0 * DEPTH) ** 0.25
DN_BETA = (8.0 * DEPTH) ** -0.25
N_MOD = 9
LN_EPS = 1e-5
RMS_EPS = 1e-6

HG_HEAD = 128
HG_HEADS = D_MODEL // HG_HEAD
HG_CHUNK = 32
POOL_WINDOWS = (2, 4, 8, 16)
POOL_GROUPS = len(POOL_WINDOWS)
POOL_WIDTH = D_MODEL // POOL_GROUPS
ML_HEADS = 8
ML_HEAD = D_MODEL // ML_HEADS
ML_CHUNK = 64
S5_GROUP = 16
S5_GROUPS = D_MODEL // S5_GROUP
S5_STATE = 64
S5_CHUNK = 128
S5_DT_MIN = 1e-3
S5_DT_MAX = 1e-1

kernel_name = "hybrid_interleaved_flow_backbone"


def layer_norm(t, g, b):
    tf = t.astype(jnp.float32)
    mu = tf.mean(-1, keepdims=True)
    var = jnp.mean(jnp.square(tf - mu), -1, keepdims=True)
    return ((tf - mu) * lax.rsqrt(var + LN_EPS)).astype(t.dtype) * g + b


def head_rms_norm(t, g, n_heads):
    shp = t.shape
    th = t.reshape(shp[:-1] + (n_heads, shp[-1] // n_heads)).astype(jnp.float32)
    th = th * lax.rsqrt(jnp.mean(jnp.square(th), -1, keepdims=True) + RMS_EPS)
    return th.reshape(shp).astype(t.dtype) * g


def modulate(t, shift, scale):
    return t * (1.0 + scale) + shift


def post_norm(z, out, gate, g, b):
    return layer_norm(DN_ALPHA * z + gate * out, g, b)


def swiglu(h, w13, w2):
    a, b = jnp.split(h @ w13, 2, axis=-1)
    return (jax.nn.silu(a) * b) @ w2


def to_chunks(t, size):
    b, n = t.shape[0], t.shape[1] // size
    return jnp.moveaxis(t.reshape((b, n, size) + t.shape[2:]), 1, 0)


def from_chunks(t):
    n, b, size = t.shape[:3]
    return jnp.moveaxis(t, 0, 1).reshape((b, n * size) + t.shape[3:])


def gla_scan(q, k, v, logf, s0):
    tri = jnp.tril(jnp.ones((HG_CHUNK, HG_CHUNK), bool))

    def step(S, inp):
        qc, kc, vc, gc = inp
        b = jnp.cumsum(gc, axis=1)
        qe, ke = qc * jnp.exp(b), kc * jnp.exp(-b)
        att = jnp.where(tri[None, None], jnp.einsum('blhk,bmhk->bhlm', qe, ke), 0.0)
        o = jnp.einsum('bhlm,bmhv->blhv', att, vc) + jnp.einsum('blhk,bhkv->blhv', qe, S)
        b_last = b[:, -1]
        kd = kc * jnp.exp(b_last[:, None] - b)
        S = jnp.exp(b_last)[..., None] * S + jnp.einsum('blhk,blhv->bhkv', kd, vc)
        return S, o

    xs = tuple(to_chunks(t, HG_CHUNK) for t in (q, k, v, logf))
    S, o = lax.scan(step, s0, xs)
    return from_chunks(o), S


def hgrn2_mixer(h, hc, w_in, lb, norm_g, w_o):
    def project(t):
        q, i, g, f_fw, f_bw = jnp.split(t @ w_in, 5, axis=-1)
        return jax.nn.silu(q), i, g, (f_fw, f_bw)

    def heads(t):
        return t.reshape(t.shape[:2] + (HG_HEADS, HG_HEAD)).astype(jnp.float32)

    def direction(p, d, s0):
        q, i, _, fz = p
        f = lb[d] + (1.0 - lb[d]) * jax.nn.sigmoid(fz[d].astype(jnp.float32))
        args = (heads(q), heads(1.0 - f), heads(i), heads(jnp.log(f)))
        if d == 1:
            args = tuple(a[:, ::-1] for a in args)
        o, s = gla_scan(*args, s0)
        return (o[:, ::-1] if d == 1 else o), s

    lat, ctx = project(h), project(hc)
    o_lat = o_ctx = 0.0
    for d in range(2):
        s0 = jnp.zeros((h.shape[0], HG_HEADS, HG_HEAD, HG_HEAD), jnp.float32)
        oc, s_ctx = direction(ctx, d, s0)
        ol, _ = direction(lat, d, s_ctx)
        o_ctx, o_lat = o_ctx + oc, o_lat + ol

    def readout(o, p, t):
        o = o.reshape(t.shape).astype(t.dtype)
        return (head_rms_norm(o, norm_g, HG_HEADS) * jax.nn.silu(p[2])) @ w_o

    return readout(o_lat, lat, h), readout(o_ctx, ctx, hc)


def centred_window_mean(t, w, axis):
    n = t.shape[axis]
    pos = np.arange(n)
    lo = np.clip(pos - w // 2, 0, n - 1)
    hi = np.clip(pos + w - w // 2 - 1, 0, n - 1)
    pad = [(0, 0)] * t.ndim
    pad[axis] = (1, 0)
    cs = jnp.pad(jnp.cumsum(t.astype(jnp.float32), axis=axis), pad)
    total = jnp.take(cs, hi + 1, axis=axis) - jnp.take(cs, lo, axis=axis)
    shape = [1] * t.ndim
    shape[axis] = n
    cnt = jnp.asarray((hi - lo + 1).reshape(shape), jnp.float32)
    return (total / cnt).astype(t.dtype)


def pool_mixer(h, hc, w_grp, scale):
    b, t_len, d = h.shape
    rows = t_len // GRID_W
    hg = h.reshape(b, rows, GRID_W, POOL_GROUPS, POOL_WIDTH)
    hcg = hc.reshape(b, hc.shape[1], POOL_GROUPS, POOL_WIDTH)

    def pooled(t, axis):
        p = jnp.stack([centred_window_mean(t[..., j, :], w, axis)
                       for j, w in enumerate(POOL_WINDOWS)], axis=-2)
        return p - t

    y = jnp.einsum('brwgi,gio->brwgo', pooled(hg, 2), w_grp).reshape(b, t_len, d) * scale
    yc = jnp.einsum('btgi,gio->btgo', pooled(hcg, 1), w_grp).reshape(hc.shape) * scale
    return y, yc


def mlstm_scan(q, k, v, logi, logf, state):
    tri = jnp.tril(jnp.ones((ML_CHUNK, ML_CHUNK), bool))

    def step(carry, inp):
        C, n, m = carry
        qc, kc, vc, ic, fc = inp
        b = jnp.cumsum(fc, axis=1)
        dmat = b[:, :, None, :] - b[:, None, :, :] + ic[:, None, :, :]
        dmat = jnp.where(tri[None, :, :, None], dmat, -jnp.inf)
        inter = b + m[:, None, :]
        m_t = jnp.maximum(inter, dmat.max(axis=2))
        w = jnp.exp(dmat - m_t[:, :, None, :])
        w_inter = jnp.exp(inter - m_t)
        qk = jnp.einsum('blhd,bshd->blsh', qc, kc) * w
        num = (jnp.einsum('blsh,bshv->blhv', qk, vc)
               + w_inter[..., None] * jnp.einsum('blhk,bhkv->blhv', qc, C))
        den = qk.sum(axis=2) + w_inter * jnp.einsum('blhk,bhk->blh', qc, n)
        hcur = num / jnp.maximum(jnp.abs(den), jnp.exp(-m_t))[..., None]
        b_last = b[:, -1]
        d_last = b_last[:, None, :] - b + ic
        m_new = jnp.maximum(b_last + m, d_last.max(axis=1))
        w_last = jnp.exp(d_last - m_new[:, None, :])
        decay = jnp.exp(b_last + m - m_new)
        C = decay[..., None, None] * C + jnp.einsum('blh,blhk,blhv->bhkv', w_last, kc, vc)
        n = decay[..., None] * n + jnp.einsum('blh,blhk->bhk', w_last, kc)
        return (C, n, m_new), hcur

    xs = tuple(to_chunks(t, ML_CHUNK) for t in (q, k, v, logi, logf))
    state, hs = lax.scan(step, state, xs)
    return from_chunks(hs), state


def mlstm_mixer(h, hc, w_in, gate_b, norm_g, w_o):
    d_mix = h.shape[-1]

    def project(t):
        z = t @ w_in
        sh = lambda a: a.reshape(t.shape[:2] + (ML_HEADS, ML_HEAD)).astype(jnp.float32)
        q, k, v, o = (z[..., j * d_mix:(j + 1) * d_mix] for j in range(4))
        gates = z[..., 4 * d_mix:].reshape(t.shape[:2] + (4, ML_HEADS)).astype(jnp.float32) + gate_b
        return sh(q), sh(k) * ML_HEAD ** -0.5, sh(v), o, gates

    def direction(p, d, state):
        q, k, v, _, gates = p
        args = (q, k, v, gates[:, :, 2 * d], jax.nn.log_sigmoid(gates[:, :, 2 * d + 1]))
        if d == 1:
            args = tuple(a[:, ::-1] for a in args)
        hcur, st = mlstm_scan(*args, state)
        return (hcur[:, ::-1] if d == 1 else hcur), st

    lat, ctx = project(h), project(hc)
    bsz = h.shape[0]
    h_lat = h_ctx = 0.0
    for d in range(2):
        st0 = (jnp.zeros((bsz, ML_HEADS, ML_HEAD, ML_HEAD), jnp.float32),
               jnp.zeros((bsz, ML_HEADS, ML_HEAD), jnp.float32),
               jnp.zeros((bsz, ML_HEADS), jnp.float32))
        hc_d, st_ctx = direction(ctx, d, st0)
        hl_d, _ = direction(lat, d, st_ctx)
        h_ctx, h_lat = h_ctx + hc_d, h_lat + hl_d

    def readout(hs, p, t):
        hs = hs.reshape(t.shape).astype(t.dtype)
        return (head_rms_norm(hs, norm_g, ML_HEADS) * jax.nn.sigmoid(p[3])) @ w_o

    return readout(h_lat, lat, h), readout(h_ctx, ctx, hc)


def s5_discretise(lam_re, lam_im, log_dt, b_re, b_im):
    dt = jnp.exp(log_dt)[:, None]
    mag = jnp.exp(lam_re * dt)
    ab_re, ab_im = mag * jnp.cos(lam_im * dt), mag * jnp.sin(lam_im * dt)
    den = lam_re ** 2 + lam_im ** 2
    nr, ni = ab_re - 1.0, ab_im
    fr = (nr * lam_re + ni * lam_im) / den
    fi = (ni * lam_re - nr * lam_im) / den
    bb_re = fr[..., None] * b_re - fi[..., None] * b_im
    bb_im = fr[..., None] * b_im + fi[..., None] * b_re
    return (ab_re, ab_im), (bb_re, bb_im)


def complex_affine_combine(e1, e2):
    a1r, a1i, x1r, x1i = e1
    a2r, a2i, x2r, x2i = e2
    return (a2r * a1r - a2i * a1i, a2r * a1i + a2i * a1r,
            a2r * x1r - a2i * x1i + x2r, a2r * x1i + a2i * x1r + x2i)


def s5_scan(u, abar, bbar, cmat, x0):
    ar, ai = abar
    br, bi = bbar
    cr, ci = cmat
    uc = jnp.swapaxes(to_chunks(u, S5_CHUNK), 1, 2)
    a_r = jnp.broadcast_to(ar[None, None], (S5_CHUNK, 1) + ar.shape)
    a_i = jnp.broadcast_to(ai[None, None], (S5_CHUNK, 1) + ai.shape)

    def step(carry, ub):
        xr, xi = carry
        bu_r = jnp.einsum('gpi,lbgi->lbgp', br, ub)
        bu_i = jnp.einsum('gpi,lbgi->lbgp', bi, ub)
        bu_r = bu_r.at[0].add(ar * xr - ai * xi)
        bu_i = bu_i.at[0].add(ar * xi + ai * xr)
        _, _, sr, si = lax.associative_scan(complex_affine_combine, (a_r, a_i, bu_r, bu_i), axis=0)
        y = jnp.einsum('gip,lbgp->lbgi', cr, sr) - jnp.einsum('gip,lbgp->lbgi', ci, si)
        return (sr[-1], si[-1]), y

    state, y = lax.scan(step, x0, uc)
    return from_chunks(jnp.swapaxes(y, 1, 2)), state


def s5_mixer(h, hc, lam_re, lam_im, log_dt, b_re, b_im, c_re, c_im, d_skip, w_glu):
    f32 = lambda a: a.astype(jnp.float32)
    groups = lambda t: t.reshape(t.shape[:2] + (S5_GROUPS, S5_GROUP)).astype(jnp.float32)
    u_lat, u_ctx = groups(h), groups(hc)
    bsz = h.shape[0]
    y_lat = y_ctx = 0.0
    for d in range(2):
        abar, bbar = s5_discretise(f32(lam_re[d]), f32(lam_im[d]), f32(log_dt[d]), f32(b_re[d]), f32(b_im[d]))
        cmat = (f32(c_re[d]), f32(c_im[d]))
        ul, ucx = (u_lat, u_ctx) if d == 0 else (u_lat[:, ::-1], u_ctx[:, ::-1])
        x0 = (jnp.zeros((bsz, S5_GROUPS, S5_STATE), jnp.float32),
              jnp.zeros((bsz, S5_GROUPS, S5_STATE), jnp.float32))
        yc, x_ctx = s5_scan(ucx, abar, bbar, cmat, x0)
        yl, _ = s5_scan(ul, abar, bbar, cmat, x_ctx)
        if d == 1:
            yc, yl = yc[:, ::-1], yl[:, ::-1]
        y_ctx, y_lat = y_ctx + yc, y_lat + yl

    def readout(y, t):
        y = y.reshape(t.shape).astype(t.dtype) + d_skip * t
        a, g = jnp.split(jax.nn.gelu(y) @ w_glu, 2, axis=-1)
        return a * jax.nn.sigmoid(g)

    return readout(y_lat, h), readout(y_ctx, hc)


def _n_slots(kind):
    return len(range(kind, DEPTH, N_MIXERS))


def setup_inputs(seed: int = 0) -> dict:
    key = jax.random.key(seed)
    ks = iter(jax.random.split(key, 64))
    nrm = lambda shape, s: jax.random.normal(next(ks), shape, jnp.float32) * s
    D, F, H = D_MODEL, D_FF, ML_HEADS
    G, P, I = S5_GROUPS, S5_STATE, S5_GROUP
    nA, nB, nC, nD = (_n_slots(k) for k in range(N_MIXERS))
    inp = {}
    inp['x'] = nrm((BATCH, SEQ, D), 1.0)
    inp['c'] = nrm((BATCH, D), 1.0)
    inp['ctx'] = nrm((BATCH, CTX_LEN, D), 1.0)
    inp['c_ctx'] = nrm((D,), 1.0)
    inp['mod_w'] = nrm((DEPTH, D, N_MOD * D), D ** -0.5)
    inp['mod_b'] = nrm((DEPTH, N_MOD * D), 0.01)
    inp['ln_g'] = 1.0 + nrm((DEPTH, 3, D), 0.01)
    inp['ln_b'] = nrm((DEPTH, 3, D), 0.01)
    inp['ffn1_w13'] = nrm((DEPTH, D, 2 * F), D ** -0.5)
    inp['ffn1_w2'] = nrm((DEPTH, F, D), F ** -0.5 * DN_BETA)
    inp['ffn2_w13'] = nrm((DEPTH, D, 2 * F), D ** -0.5)
    inp['ffn2_w2'] = nrm((DEPTH, F, D), F ** -0.5 * DN_BETA)
    inp['hg_w_in'] = nrm((nA, D, 5 * D), D ** -0.5)
    inp['hg_lb_logits'] = nrm((2, DEPTH, D), 0.1)
    inp['hg_norm_g'] = 1.0 + nrm((nA, D), 0.01)
    inp['hg_w_o'] = nrm((nA, D, D), D ** -0.5 * DN_BETA)
    inp['pool_w'] = nrm((nB, POOL_GROUPS, POOL_WIDTH, POOL_WIDTH), POOL_WIDTH ** -0.5 * DN_BETA)
    inp['pool_scale'] = 1.0 + nrm((nB, D), 0.01)
    inp['ml_w_in'] = nrm((nC, D, 4 * D + 4 * H), D ** -0.5)
    forget_bias = jnp.linspace(3.0, 6.0, H, dtype=jnp.float32)
    is_forget = jnp.array([0.0, 1.0, 0.0, 1.0], jnp.float32)[:, None]
    inp['ml_gate_b'] = nrm((nC, 4, H), 0.1) + is_forget * forget_bias
    inp['ml_norm_g'] = 1.0 + nrm((nC, D), 0.01)
    inp['ml_w_o'] = nrm((nC, D, D), D ** -0.5 * DN_BETA)
    inp['s5_lam_re'] = -0.5 + nrm((nD, 2, G, P), 0.01)
    inp['s5_lam_im'] = jnp.pi * jnp.arange(P, dtype=jnp.float32) + nrm((nD, 2, G, P), 0.01)
    inp['s5_log_dt'] = jax.random.uniform(next(ks), (nD, 2, G), jnp.float32,
                                          np.log(S5_DT_MIN), np.log(S5_DT_MAX))
    inp['s5_b_re'] = nrm((nD, 2, G, P, I), I ** -0.5)
    inp['s5_b_im'] = nrm((nD, 2, G, P, I), I ** -0.5)
    inp['s5_c_re'] = nrm((nD, 2, G, I, P), P ** -0.5)
    inp['s5_c_im'] = nrm((nD, 2, G, I, P), P ** -0.5)
    inp['s5_d'] = nrm((nD, D), 1.0)
    inp['s5_w_glu'] = jnp.concatenate([nrm((nD, D, D), D ** -0.5 * DN_BETA),
                                       nrm((nD, D, D), D ** -0.5)], axis=-1)
    return inp


def reference(x, c, ctx, c_ctx, mod_w, mod_b, ln_g, ln_b, ffn1_w13, ffn1_w2, ffn2_w13, ffn2_w2,
              hg_w_in, hg_lb_logits, hg_norm_g, hg_w_o, pool_w, pool_scale,
              ml_w_in, ml_gate_b, ml_norm_g, ml_w_o,
              s5_lam_re, s5_lam_im, s5_log_dt, s5_b_re, s5_b_im, s5_c_re, s5_c_im, s5_d, s5_w_glu):
    lb_all = jnp.cumsum(jax.nn.softmax(hg_lb_logits.astype(jnp.float32), axis=1), axis=1)
    for i in range(DEPTH):
        kind, slot = i % N_MIXERS, i // N_MIXERS
        ml = jnp.split((jax.nn.silu(c) @ mod_w[i] + mod_b[i])[:, None, :], N_MOD, axis=-1)
        mc = jnp.split((jax.nn.silu(c_ctx) @ mod_w[i] + mod_b[i])[None, None, :], N_MOD, axis=-1)
        x = post_norm(x, 0.5 * swiglu(modulate(x, ml[0], ml[1]), ffn1_w13[i], ffn1_w2[i]),
                      ml[2], ln_g[i, 0], ln_b[i, 0])
        ctx = post_norm(ctx, 0.5 * swiglu(modulate(ctx, mc[0], mc[1]), ffn1_w13[i], ffn1_w2[i]),
                        mc[2], ln_g[i, 0], ln_b[i, 0])
        h, hc = modulate(x, ml[3], ml[4]), modulate(ctx, mc[3], mc[4])
        if kind == 0:
            y, yc = hgrn2_mixer(h, hc, hg_w_in[slot], lb_all[:, i], hg_norm_g[slot], hg_w_o[slot])
        elif kind == 1:
            y, yc = pool_mixer(h, hc, pool_w[slot], pool_scale[slot])
        elif kind == 2:
            y, yc = mlstm_mixer(h, hc, ml_w_in[slot], ml_gate_b[slot], ml_norm_g[slot], ml_w_o[slot])
        else:
            y, yc = s5_mixer(h, hc, s5_lam_re[slot], s5_lam_im[slot], s5_log_dt[slot],
                             s5_b_re[slot], s5_b_im[slot], s5_c_re[slot], s5_c_im[slot],
                             s5_d[slot], s5_w_glu[slot])
        x = post_norm(x, y, ml[5], ln_g[i, 1], ln_b[i, 1])
        x = post_norm(x, 0.5 * swiglu(modulate(x, ml[6], ml[7]), ffn2_w13[i], ffn2_w2[i]),
                      ml[8], ln_g[i, 2], ln_b[i, 2])
        if i < DEPTH - 1:
            ctx = post_norm(ctx, yc, mc[5], ln_g[i, 1], ln_b[i, 1])
            ctx = post_norm(ctx, 0.5 * swiglu(modulate(ctx, mc[6], mc[7]), ffn2_w13[i], ffn2_w2[i]),
                            mc[8], ln_g[i, 2], ln_b[i, 2])
    return x
```

```cpp
#include <hip/hip_runtime.h>
#include <cstdio>
#include <cstdint>

#ifndef MK_MULTI
#define MK_MULTI 0
#endif

#define LAS __attribute__((address_space(3)))
typedef unsigned short bf16;
typedef short bf16x8 __attribute__((ext_vector_type(8)));
typedef float f32x4 __attribute__((ext_vector_type(4)));
typedef float f32x2 __attribute__((ext_vector_type(2)));
typedef unsigned u32x4 __attribute__((ext_vector_type(4)));
typedef unsigned u32x2 __attribute__((ext_vector_type(2)));

constexpr int D = 2048, NB = 8, T = 4096, CT = 256, DEPTH = 4, FF = 5632, NMOD = 9;
constexpr int RL = NB * T;
constexpr int RC = NB * CT;
constexpr int R = RL + RC;
constexpr int MODW = NMOD * D;
constexpr float DN_ALPHA = 1.6817928305074290f;
constexpr float LN_EPS = 1e-5f, RMS_EPS = 1e-6f;
constexpr int MLN = 8448;

constexpr size_t MiB = 1u << 20;
constexpr size_t WS_CTL = 0, CTL_BYTES = 1 * MiB;
constexpr size_t WS_MODV = 1 * MiB;
constexpr size_t WS_LB = 4 * MiB;
constexpr size_t WS_S5A = 5 * MiB;
constexpr size_t WS_S5B = 6 * MiB;
constexpr size_t WS_GATES = 8 * MiB;
constexpr size_t WS_HGIN = 17 * MiB;
constexpr size_t WS_HGO = 57 * MiB;
constexpr size_t WS_POOLW = 65 * MiB;
constexpr size_t WS_MLIN = 67 * MiB;
constexpr size_t WS_MLO = 100 * MiB;
constexpr size_t WS_GLU = 108 * MiB;
constexpr size_t WS_W13A = 124 * MiB, WS_W2A = 168 * MiB, WS_W13B = 190 * MiB, WS_W2B = 234 * MiB;
constexpr size_t WS_XZ = 256 * MiB;
constexpr size_t WS_H = 528 * MiB;
constexpr size_t WS_BIG = 664 * MiB;
constexpr size_t WS_END = (664 + 1224) * MiB;
constexpr size_t BIG_O1_HG = 680 * MiB, BIG_O2_HG = 952 * MiB;
constexpr size_t BIG_O1_ML = 544 * MiB, BIG_O2_ML = 816 * MiB;
constexpr size_t BIG_O1_S5 = 0, BIG_O2_S5 = 272 * MiB;
constexpr int CW_BAR = 4096;

constexpr int RING_BYTES = 131072, MISC_OFF = RING_BYTES + 320, LDS_BYTES = 147456;

__device__ __forceinline__ float bf_lo(unsigned w) { return __uint_as_float(w << 16); }
__device__ __forceinline__ float bf_hi(unsigned w) { return __uint_as_float(w & 0xffff0000u); }
__device__ __forceinline__ unsigned cvt_pk_bf16(float lo, float hi) { unsigned r; asm volatile("v_cvt_pk_bf16_f32 %0, %1, %2" : "=v"(r) : "v"(lo), "v"(hi)); return r; }
__device__ __forceinline__ float fsigmoid(float x) { return __builtin_amdgcn_rcpf(1.0f + __expf(-x)); }
__device__ __forceinline__ float fsilu(float x) { return x * fsigmoid(x); }
__device__ __forceinline__ float gelu_tanh(float x) { const float u = 1.5957691216057308f * (x + 0.044715f * x * x * x); return x * fsigmoid(u); }
__device__ __forceinline__ float wave_sum(float v) {
#pragma unroll
    for (int o = 1; o < 64; o <<= 1) v += __shfl_xor(v, o);
    return v;
}
__device__ __forceinline__ int row_batch(int r) { return r < RL ? (r >> 12) : NB; }
__device__ __forceinline__ int scan_row(int b, int d, int n) {
    if (n < CT) return RL + b * CT + (d ? CT - 1 - n : n);
    const int m = n - CT; return b * T + (d ? T - 1 - m : m);
}
constexpr int NSTEP = CT + T;

#define XB_TMO      128
#define XB_XCNT(j)  (256  + 64 * (j))
#define XB_XSUB(j)  (1280 + 64 * (j))
#define XB_XGEN(j)  (2304 + 64 * (j))
#define XB_TOP      3328
#define XB_TOPGEN   3392
#define XCD_BAR_WORDS 3456
#define XB_SPIN_CAP (1u << 18)
__device__ __forceinline__ unsigned xb_ld(unsigned* p)              { return __hip_atomic_load(p, __ATOMIC_RELAXED, __HIP_MEMORY_SCOPE_AGENT); }
__device__ __forceinline__ unsigned xb_add(unsigned* p, unsigned v) { return __hip_atomic_fetch_add(p, v, __ATOMIC_RELAXED, __HIP_MEMORY_SCOPE_AGENT); }
__device__ __forceinline__ unsigned xb_xcc_id() { return (unsigned)__builtin_amdgcn_s_getreg((3 << 11) | 20) & 0xFu; }
#define XB_SPIN(cond, bar) do { unsigned _sp = 0; while (cond) { __builtin_amdgcn_s_sleep(1); \
    if ((++_sp & 255u) == 0u) { if (xb_ld(&(bar)[XB_TMO])) break; if (_sp > XB_SPIN_CAP) { atomicAdd(&(bar)[XB_TMO], 1u); break; } } } } while (0)
struct XcdBarrier { unsigned* bar; unsigned x; volatile LAS unsigned* st; };
__device__ __forceinline__ XcdBarrier xcd_barrier_post(unsigned* bar, volatile LAS unsigned* st) {
    XcdBarrier b; b.bar = bar; b.x = xb_xcc_id(); b.st = st;
    if (threadIdx.x == 0) (void)xb_add(&bar[XB_XCNT(b.x)], 1u);
    return b;
}
__device__ __forceinline__ void xcd_barrier_complete(unsigned* bar, unsigned x, unsigned& nloc, unsigned& nx) {
    const unsigned G = gridDim.x * gridDim.y * gridDim.z;
    unsigned sum, cnt, mine, sp = 0u;
    for (;;) {
        sum = 0u; cnt = 0u; mine = 0u;
#pragma unroll
        for (unsigned j = 0; j < 16; ++j) { const unsigned c = xb_ld(&bar[XB_XCNT(j)]); sum += c; cnt += (c > 0u) ? 1u : 0u; mine = (j == x) ? c : mine; }
        if (sum == G) break;
        __builtin_amdgcn_s_sleep(1);
        if ((++sp & 255u) == 0u) { if (xb_ld(&bar[XB_TMO])) break; if (sp > XB_SPIN_CAP) { atomicAdd(&bar[XB_TMO], 1u); break; } }
    }
    nloc = mine > 0u ? mine : 1u; nx = cnt > 0u ? cnt : 1u;
}
__device__ __forceinline__ void xcd_barrier(const XcdBarrier& b) {
    asm volatile("s_waitcnt vmcnt(0)" ::: "memory");
    __syncthreads();
    if (threadIdx.x == 0) {
        unsigned* bar = b.bar;
        __builtin_amdgcn_s_waitcnt(0);
        unsigned nloc = b.st[0], nx = b.st[1];
        if (nloc == 0u) { xcd_barrier_complete(bar, b.x, nloc, nx); b.st[0] = nloc; b.st[1] = nx; }
        const unsigned old = xb_add(&bar[XB_XSUB(b.x)], 1u);
        const unsigned gen = old / nloc;
        if (old + 1u == (gen + 1u) * nloc) {
            __builtin_amdgcn_fence(__ATOMIC_RELEASE, "agent");
            asm volatile("s_waitcnt vmcnt(0)" ::: "memory");
            const unsigned og = xb_add(&bar[XB_TOP], 1u);
            const unsigned tg = og / nx;
            if (og + 1u == (tg + 1u) * nx) xb_add(&bar[XB_TOPGEN], 1u);
            else XB_SPIN(xb_ld(&bar[XB_TOPGEN]) == tg, bar);
            __builtin_amdgcn_fence(__ATOMIC_ACQUIRE, "agent");
            xb_add(&bar[XB_XGEN(b.x)], 1u);
            asm volatile("s_waitcnt vmcnt(0)" ::: "memory");
        } else {
            XB_SPIN(xb_ld(&bar[XB_XGEN(b.x)]) == gen, bar);
            __builtin_amdgcn_fence(__ATOMIC_ACQUIRE, "agent");
            asm volatile("s_waitcnt vmcnt(0)" ::: "memory");
        }
    }
    __syncthreads();
}

namespace pg8 {
constexpr int BM = 256, BK = 64, HALF = 128, HTB = HALF * BK * 2, STAGE_BYTES = 8 * HTB, NXCD = 8, WGM = 8;
__host__ __device__ __forceinline__ int lds_byte(int r, int c) { const int st = (r >> 4) * 2 + (c >> 5), rr = r & 15, cc = c & 31, ob = rr * 64 + cc * 2; return st * 1024 + (ob ^ (((ob >> 9) & 1) << 5)); }
__host__ __device__ __forceinline__ void stage_rc(int b, int& Rr, int& C) { const int st = b / 1024, sb = b % 1024, swz = sb ^ (((sb >> 9) & 1) << 5); Rr = (st >> 1) * 16 + swz / 64; C = (st & 1) * 32 + (swz % 64) / 2; }
__host__ __device__ __forceinline__ int perm32(int rho) { const int n = rho >> 4, i = rho & 15; return 8 * (i >> 2) + 4 * n + (i & 3); }
struct Unit { int pm, pn; };
struct Gemm { const bf16* A; const bf16* Bt; int M, N, K, lda, ldb, agrp; };
struct StaticOrder {
    int nM, nN, nwg, G, c;
    __device__ void init(int M, int N, int G_, int c_) { nM = M / BM; nN = N / BM; nwg = nM * nN; G = G_; c = c_; }
    __device__ bool next(int i, Unit& u) const {
        const long L = (long)i * G + c; if (L >= nwg) return false;
        int wgid = (int)L; { const int q = nwg / NXCD, r = nwg % NXCD, xcd = wgid % NXCD, off = wgid / NXCD; wgid = (xcd < r ? xcd * (q + 1) : r * (q + 1) + (xcd - r) * q) + off; }
        const int nig = WGM * nN, gid = wgid / nig, fm = gid * WGM, gsz = (nM - fm) < WGM ? (nM - fm) : WGM;
        u.pm = fm + ((wgid % nig) % gsz); u.pn = (wgid % nig) / gsz; return true;
    }
};
template <class Epi>
__device__ __forceinline__ void gemm_phase(LAS unsigned char* lds, const Gemm g, const Epi& E) {
    const int tid = threadIdx.x, wid = __builtin_amdgcn_readfirstlane(tid >> 6), lane = tid & 63, wr = wid >> 2, wc = wid & 3, fr = lane & 15, fq = lane >> 4;
    const int K = g.K, nt = K / BK;
    StaticOrder S; S.init(g.M, g.N, (int)gridDim.x, (int)blockIdx.x);
    unsigned voffA[2], voffB[2];
#pragma unroll
    for (int i = 0; i < 2; ++i) { int Rr, C; stage_rc(tid * 16 + i * 8192, Rr, C); const int Rb = Epi::PERM ? ((Rr & ~31) + perm32(Rr & 31)) : Rr;
        voffA[i] = (unsigned)(Rr * g.lda + C) * 2u; voffB[i] = (unsigned)(Rb * g.ldb + C) * 2u; }
    const size_t kstep = (size_t)(BK * 2);
    const size_t hstepA = (size_t)HALF * g.lda * 2, hstepB = (size_t)HALF * g.ldb * 2;
    const size_t tstepA = 2 * hstepA, tstepB = 2 * hstepB;
    const unsigned ldsw = (unsigned)wid * 1024u;
    const int aoff = lds_byte(wr * 64 + fr, fq * 8), boff = lds_byte(wc * 32 + fr, fq * 8);
#define PG8_ABASE(u) ((const char*)g.A + (size_t)(u).pm * tstepA + (g.agrp ? (size_t)((u).pn / g.agrp) * (size_t)K * 2 : (size_t)0))
#define PG8_BBASE(u) ((const char*)g.Bt + (size_t)(u).pn * tstepB)
#define PG8_SA(b, h) (((b) * 2 + (h)) * HTB)
#define PG8_SB(b, h) ((4 + (b) * 2 + (h)) * HTB)
#define PG8_STAGE(bufoff, gbase, voff) do { _Pragma("unroll") for (int _i = 0; _i < 2; ++_i) \
        __builtin_amdgcn_global_load_lds((const unsigned*)((const char*)(gbase) + (voff)[_i]), (LAS unsigned*)(lds + (bufoff) + ldsw + _i * 8192), 16, 0, 0); } while (0)
#define PG8_LDA(dst, b, h) do { _Pragma("unroll") for (int m = 0; m < 4; ++m) _Pragma("unroll") for (int k = 0; k < 2; ++k) dst[m][k] = *(const LAS bf16x8*)(lds + PG8_SA(b, h) + aoff + m * 2048 + k * 1024); } while (0)
#define PG8_LDB(dst, b, h) do { _Pragma("unroll") for (int n = 0; n < 2; ++n) _Pragma("unroll") for (int k = 0; k < 2; ++k) dst[n][k] = *(const LAS bf16x8*)(lds + PG8_SB(b, h) + boff + n * 2048 + k * 1024); } while (0)
#define PG8_MMA(ai, bj, At, Bt) do { __builtin_amdgcn_s_setprio(1); _Pragma("unroll") for (int m = 0; m < 4; ++m) _Pragma("unroll") for (int n = 0; n < 2; ++n) _Pragma("unroll") for (int k = 0; k < 2; ++k) \
        acc[ai][bj][m][n] = __builtin_amdgcn_mfma_f32_16x16x32_bf16(Bt[n][k], At[m][k], acc[ai][bj][m][n], 0, 0, 0); __builtin_amdgcn_s_setprio(0); } while (0)
#define PG8_WAIT_V(n) asm volatile("s_waitcnt vmcnt(" #n ")" ::: "memory")
#define PG8_WAIT_L(n) asm volatile("s_waitcnt lgkmcnt(" #n ")" ::: "memory")
#define PG8_BAR __builtin_amdgcn_s_barrier()
#define PG8_SCHED __builtin_amdgcn_sched_barrier(0)
    Unit cur, nxt; int ui = 0;
    if (!S.next(0, cur)) return;
    f32x4 acc[2][2][4][2];
#pragma unroll
    for (int a = 0; a < 2; ++a)
#pragma unroll
        for (int b = 0; b < 2; ++b)
#pragma unroll
            for (int m = 0; m < 4; ++m)
#pragma unroll
                for (int n = 0; n < 2; ++n) acc[a][b][m][n] = (f32x4){0.f, 0.f, 0.f, 0.f};
    bf16x8 At[4][2], B0[2][2], B1[2][2];
    const char* cA = PG8_ABASE(cur); const char* cB = PG8_BBASE(cur);
    PG8_STAGE(PG8_SB(0, 0), cB, voffB); PG8_STAGE(PG8_SB(0, 1), cB + hstepB, voffB); PG8_STAGE(PG8_SA(0, 0), cA, voffA); PG8_STAGE(PG8_SA(0, 1), cA + hstepA, voffA);
    if (wr == 1) PG8_BAR;
    PG8_WAIT_V(2); PG8_BAR;
    PG8_STAGE(PG8_SB(1, 0), cB + kstep, voffB); PG8_STAGE(PG8_SA(1, 0), cA + kstep, voffA); PG8_STAGE(PG8_SB(1, 1), cB + hstepB + kstep, voffB);
    PG8_WAIT_V(6); PG8_BAR;
    for (;;) {
        const bool has_next = S.next(ui + 1, nxt);
        const char* nA = has_next ? PG8_ABASE(nxt) : cA; const char* nB = has_next ? PG8_BBASE(nxt) : cB;
        for (int t = 0; t < nt; t += 2) {
            const bool last = (t == nt - 2);
            const char* a1 = cA + (size_t)(t + 1) * kstep;
            const char* a2 = last ? nA : cA + (size_t)(t + 2) * kstep; const char* b2 = last ? nB : cB + (size_t)(t + 2) * kstep;
            const char* a3 = a2 + kstep; const char* b3 = b2 + kstep;
            PG8_LDB(B0, 0, 0); PG8_LDB(B1, 0, 1); PG8_SCHED; PG8_LDA(At, 0, 0); PG8_STAGE(PG8_SA(1, 1), a1 + hstepA, voffA);
            PG8_WAIT_V(8); PG8_WAIT_L(0); PG8_BAR; PG8_MMA(0, 0, At, B0); PG8_MMA(0, 1, At, B1); PG8_BAR; PG8_SCHED;
            PG8_LDA(At, 0, 1); PG8_STAGE(PG8_SB(0, 0), b2, voffB); PG8_STAGE(PG8_SB(0, 1), b2 + hstepB, voffB); PG8_STAGE(PG8_SA(0, 0), a2, voffA);
            PG8_WAIT_V(8); PG8_WAIT_L(0); PG8_BAR; PG8_MMA(1, 0, At, B0); PG8_MMA(1, 1, At, B1); PG8_BAR; PG8_SCHED;
            PG8_LDB(B0, 1, 0); PG8_LDB(B1, 1, 1); PG8_SCHED; PG8_LDA(At, 1, 0); PG8_STAGE(PG8_SA(0, 1), a2 + hstepA, voffA);
            PG8_WAIT_V(8); PG8_WAIT_L(0); PG8_BAR; PG8_MMA(0, 0, At, B0); PG8_MMA(0, 1, At, B1); PG8_BAR; PG8_SCHED;
            PG8_LDA(At, 1, 1); PG8_STAGE(PG8_SB(1, 0), b3, voffB); PG8_STAGE(PG8_SB(1, 1), b3 + hstepB, voffB); PG8_STAGE(PG8_SA(1, 0), a3, voffA);
            PG8_WAIT_V(8); PG8_WAIT_L(0); PG8_BAR; PG8_MMA(1, 0, At, B0); PG8_MMA(1, 1, At, B1); PG8_BAR; PG8_SCHED;
        }
        if (wr == 0) PG8_BAR;
        E(acc, cur, wr, wc, fr, fq);
        if (!has_next) break;
#pragma unroll
        for (int a = 0; a < 2; ++a)
#pragma unroll
            for (int b = 0; b < 2; ++b)
#pragma unroll
                for (int m = 0; m < 4; ++m)
#pragma unroll
                    for (int n = 0; n < 2; ++n) acc[a][b][m][n] = (f32x4){0.f, 0.f, 0.f, 0.f};
        cur = nxt; cA = nA; cB = nB; ++ui;
        if (wr == 1) PG8_BAR;
    }
    PG8_WAIT_V(0);
    PG8_BAR;
#undef PG8_ABASE
#undef PG8_BBASE
#undef PG8_SA
#undef PG8_SB
#undef PG8_STAGE
#undef PG8_LDA
#undef PG8_LDB
#undef PG8_MMA
#undef PG8_WAIT_V
#undef PG8_WAIT_L
#undef PG8_BAR
#undef PG8_SCHED
}
}
using pg8::Unit; using pg8::HALF; using pg8::BM;
typedef f32x4 Acc[2][2][4][2];

struct EpiSwiglu {
    static constexpr bool PERM = true;
    bf16* O;
    __device__ __forceinline__ void operator()(const Acc& acc, const Unit& u, int wr, int wc, int fr, int fq) const {
        const int row0 = u.pm * BM + wr * 64 + fr, col0 = u.pn * HALF + wc * 32 + 8 * fq;
#pragma unroll
        for (int ai = 0; ai < 2; ++ai)
#pragma unroll
            for (int m = 0; m < 4; ++m) {
                float h[8];
#pragma unroll
                for (int n = 0; n < 2; ++n)
#pragma unroll
                    for (int j = 0; j < 4; ++j) { const float a = acc[ai][0][m][n][j], b = acc[ai][1][m][n][j]; h[4 * n + j] = fsilu(a) * b; }
                u32x4 w; w.x = cvt_pk_bf16(h[0], h[1]); w.y = cvt_pk_bf16(h[2], h[3]); w.z = cvt_pk_bf16(h[4], h[5]); w.w = cvt_pk_bf16(h[6], h[7]);
                *(u32x4*)(O + (size_t)(row0 + ai * HALF + m * 16) * FF + col0) = w;
            }
    }
};
struct EpiResid {
    static constexpr bool PERM = false;
    float* XZ; const float* modl; int gate_idx; float fac; const float* colscale;
    __device__ __forceinline__ void operator()(const Acc& acc, const Unit& u, int wr, int wc, int fr, int fq) const {
        const int row0 = u.pm * BM + wr * 64 + fr, col0 = u.pn * BM + wc * 32 + 4 * fq;
        const float* gp = modl + (size_t)(u.pm < RL / 256 ? (u.pm >> 4) : NB) * MODW + gate_idx * D;
        f32x4 gv[2][2];
#pragma unroll
        for (int bj = 0; bj < 2; ++bj)
#pragma unroll
            for (int n = 0; n < 2; ++n) { const int c = col0 + bj * HALF + n * 16; gv[bj][n] = *(const f32x4*)(gp + c) * fac; if (colscale) gv[bj][n] *= *(const f32x4*)(colscale + c); }
#pragma unroll
        for (int ai = 0; ai < 2; ++ai)
#pragma unroll
            for (int m = 0; m < 4; ++m) { float* rowp = XZ + (size_t)(row0 + ai * HALF + m * 16) * D + col0;
#pragma unroll
                for (int bj = 0; bj < 2; ++bj)
#pragma unroll
                    for (int n = 0; n < 2; ++n) { f32x4* p = (f32x4*)(rowp + bj * HALF + n * 16); const f32x4 x = *p; *p = x * DN_ALPHA + gv[bj][n] * acc[ai][bj][m][n]; }
                asm volatile("" ::: "memory"); }
    }
};
struct EpiHgIn {
    static constexpr bool PERM = true;
    bf16* O; const float* lb;
    __device__ __forceinline__ void operator()(const Acc& acc, const Unit& u, int wr, int wc, int fr, int fq) const {
        const int row0 = u.pm * BM + wr * 64 + fr, col0 = u.pn * BM + wc * 32 + 8 * fq, type = u.pn >> 3;
        float om[2][8];
        if (type >= 3) {
#pragma unroll
            for (int bj = 0; bj < 2; ++bj)
#pragma unroll
                for (int j = 0; j < 8; ++j) om[bj][j] = 1.0f - lb[(type - 3) * D + (col0 + bj * HALF + j - (3 + (type - 3)) * D)];
        }
#pragma unroll
        for (int ai = 0; ai < 2; ++ai)
#pragma unroll
            for (int m = 0; m < 4; ++m) { bf16* rowp = O + (size_t)(row0 + ai * HALF + m * 16) * (5 * D) + col0;
#pragma unroll
                for (int bj = 0; bj < 2; ++bj) { float v[8];
#pragma unroll
                    for (int n = 0; n < 2; ++n)
#pragma unroll
                        for (int j = 0; j < 4; ++j) { const float z = acc[ai][bj][m][n][j]; float o;
                            if (type == 0 || type == 2) o = fsilu(z); else if (type == 1) o = z; else o = om[bj][4 * n + j] * fsigmoid(-z);
                            v[4 * n + j] = o; }
                    u32x4 w; w.x = cvt_pk_bf16(v[0], v[1]); w.y = cvt_pk_bf16(v[2], v[3]); w.z = cvt_pk_bf16(v[4], v[5]); w.w = cvt_pk_bf16(v[6], v[7]);
                    *(u32x4*)(rowp + bj * HALF) = w; } }
    }
};
struct EpiMlIn {
    static constexpr bool PERM = true;
    bf16* O; float* gates; const float* gate_b;
    __device__ __forceinline__ void operator()(const Acc& acc, const Unit& u, int wr, int wc, int fr, int fq) const {
        const int row0 = u.pm * BM + wr * 64 + fr, type = u.pn >> 3;
        if (type < 4) {
            const int col0 = u.pn * BM + wc * 32 + 8 * fq;
#pragma unroll
            for (int ai = 0; ai < 2; ++ai)
#pragma unroll
                for (int m = 0; m < 4; ++m) { bf16* rowp = O + (size_t)(row0 + ai * HALF + m * 16) * (4 * D) + col0;
#pragma unroll
                    for (int bj = 0; bj < 2; ++bj) { float v[8];
#pragma unroll
                        for (int n = 0; n < 2; ++n)
#pragma unroll
                            for (int j = 0; j < 4; ++j) { const float z = acc[ai][bj][m][n][j]; v[4 * n + j] = type == 1 ? z * 0.0625f : (type == 3 ? fsigmoid(z) : z); }
                        u32x4 w; w.x = cvt_pk_bf16(v[0], v[1]); w.y = cvt_pk_bf16(v[2], v[3]); w.z = cvt_pk_bf16(v[4], v[5]); w.w = cvt_pk_bf16(v[6], v[7]);
                        *(u32x4*)(rowp + bj * HALF) = w; } }
        } else if (wc == 0) {
            float gb[8];
#pragma unroll
            for (int j = 0; j < 8; ++j) gb[j] = gate_b[8 * fq + j];
#pragma unroll
            for (int ai = 0; ai < 2; ++ai)
#pragma unroll
                for (int m = 0; m < 4; ++m) { float* gp = gates + (size_t)(row0 + ai * HALF + m * 16) * 32 + 8 * fq;
#pragma unroll
                    for (int n = 0; n < 2; ++n) { f32x4 o;
#pragma unroll
                        for (int j = 0; j < 4; ++j) { float z = acc[ai][0][m][n][j] + gb[4 * n + j];
                            if (fq & 1) z = fminf(z, 0.f) - log1pf(expf(-fabsf(z)));
                            o[j] = z; }
                        *(f32x4*)(gp + 4 * n) = o; } }
        }
    }
};
struct EpiS5Glu {
    static constexpr bool PERM = true;
    float* XZ; const float* modl; int gate_idx;
    __device__ __forceinline__ void operator()(const Acc& acc, const Unit& u, int wr, int wc, int fr, int fq) const {
        const int row0 = u.pm * BM + wr * 64 + fr, col0 = u.pn * HALF + wc * 32 + 8 * fq;
        const float* gp = modl + (size_t)(u.pm < RL / 256 ? (u.pm >> 4) : NB) * MODW + gate_idx * D + col0;
        const f32x4 g0 = *(const f32x4*)gp, g1 = *(const f32x4*)(gp + 4);
#pragma unroll
        for (int ai = 0; ai < 2; ++ai)
#pragma unroll
            for (int m = 0; m < 4; ++m) { float* rowp = XZ + (size_t)(row0 + ai * HALF + m * 16) * D + col0;
#pragma unroll
                for (int n = 0; n < 2; ++n) { f32x4 y;
#pragma unroll
                    for (int j = 0; j < 4; ++j) y[j] = acc[ai][0][m][n][j] * fsigmoid(acc[ai][1][m][n][j]);
                    f32x4* p = (f32x4*)(rowp + 4 * n); const f32x4 x = *p; *p = x * DN_ALPHA + (n ? g1 : g0) * y; } }
    }
};

__device__ __forceinline__ void transpose_item(const float* W, int N, bf16* WT, int ldk, int mode, int NH, LAS float* scr, int item, int lane) {
    const int nblk = N / 32, kb = item / nblk, nb = item % nblk, k0 = 64 * kb, n0 = 32 * nb;
#pragma unroll 8
    for (int i = 0; i < 32; ++i) { const int kk = 2 * i + (lane >> 5); scr[kk * 33 + (lane & 31)] = W[(size_t)(k0 + kk) * N + n0 + (lane & 31)]; }
    asm volatile("s_waitcnt lgkmcnt(0)" ::: "memory");
    int r0 = n0;
    if (mode == 1) { const int half = n0 / NH, j = n0 - half * NH; r0 = 256 * (j >> 7) + 128 * half + (j & 127); }
    const int c = lane & 7;
#pragma unroll
    for (int j = 0; j < 4; ++j) { const int n = (lane >> 3) + 8 * j; const LAS float* s = scr + (8 * c) * 33 + n;
        u32x4 o; o.x = cvt_pk_bf16(s[0 * 33], s[1 * 33]); o.y = cvt_pk_bf16(s[2 * 33], s[3 * 33]); o.z = cvt_pk_bf16(s[4 * 33], s[5 * 33]); o.w = cvt_pk_bf16(s[6 * 33], s[7 * 33]);
        *(u32x4*)(WT + (size_t)(r0 + n) * ldk + k0 + 8 * c) = o; }
    asm volatile("s_waitcnt lgkmcnt(0)" ::: "memory");
}
__device__ __forceinline__ void convert_ffn_layer(const float* w13a, const float* w2a, const float* w13b, const float* w2b, unsigned char* ws, LAS float* scr, int gw, int NGW, int lane) {
    constexpr int I13 = (D / 64) * (2 * FF / 32), I2 = (FF / 64) * (D / 32);
    for (int it = gw; it < 2 * (I13 + I2); it += NGW) {
        int r = it;
        if (r < I13) { transpose_item(w13a, 2 * FF, (bf16*)(ws + WS_W13A), D, 1, FF, scr, r, lane); continue; } r -= I13;
        if (r < I2) { transpose_item(w2a, D, (bf16*)(ws + WS_W2A), FF, 0, 0, scr, r, lane); continue; } r -= I2;
        if (r < I13) { transpose_item(w13b, 2 * FF, (bf16*)(ws + WS_W13B), D, 1, FF, scr, r, lane); continue; } r -= I13;
        transpose_item(w2b, D, (bf16*)(ws + WS_W2B), FF, 0, 0, scr, r, lane);
    }
}

template <int MODE>
__device__ __forceinline__ void row_phase(int gw, int NGW, int lane, int nrows, const float* xin, const float* ctxin, float* XZ, bf16* H,
                                          const float* lng, const float* lnb, const float* modl, int shift_idx, int scale_idx, float* out) {
    for (int r = gw; r < nrows; r += NGW) {
        const float* src = MODE == 0 ? (r < RL ? xin + (size_t)r * D : ctxin + (size_t)(r - RL) * D) : XZ + (size_t)r * D;
        f32x4 v[8];
#pragma unroll
        for (int j = 0; j < 8; ++j) v[j] = *(const f32x4*)(src + 4 * lane + 256 * j);
        if (MODE == 1) {
            float s = 0.f;
#pragma unroll
            for (int j = 0; j < 8; ++j) s += (v[j].x + v[j].y) + (v[j].z + v[j].w);
            const float mean = wave_sum(s) * (1.f / D); float s2 = 0.f;
#pragma unroll
            for (int j = 0; j < 8; ++j) { v[j] = v[j] - mean; s2 += (v[j].x * v[j].x + v[j].y * v[j].y) + (v[j].z * v[j].z + v[j].w * v[j].w); }
            const float rstd = 1.f / sqrtf(wave_sum(s2) * (1.f / D) + LN_EPS);
#pragma unroll
            for (int j = 0; j < 8; ++j) { const f32x4 gg = *(const f32x4*)(lng + 4 * lane + 256 * j), bb = *(const f32x4*)(lnb + 4 * lane + 256 * j); v[j] = v[j] * rstd * gg + bb; }
        }
#pragma unroll
        for (int j = 0; j < 8; ++j) *(f32x4*)(XZ + (size_t)r * D + 4 * lane + 256 * j) = v[j];
        if (out && r < RL) {
#pragma unroll
            for (int j = 0; j < 8; ++j) *(f32x4*)(out + (size_t)r * D + 4 * lane + 256 * j) = v[j];
        }
        if (H) {
            const float* mp = modl + (size_t)row_batch(r) * MODW;
#pragma unroll
            for (int j = 0; j < 8; ++j) { const int c = 4 * lane + 256 * j; const f32x4 sh = *(const f32x4*)(mp + shift_idx * D + c), sc = *(const f32x4*)(mp + scale_idx * D + c);
                const f32x4 h = v[j] * (sc + 1.0f) + sh; u32x2 w; w.x = cvt_pk_bf16(h.x, h.y); w.y = cvt_pk_bf16(h.z, h.w);
                *(u32x2*)(H + (size_t)r * D + c) = w; }
        }
    }
}
__device__ __forceinline__ void pool_phase(int gw, int NGW, int lane, const float* XZ, bf16* H, const float* modl, int scale_idx) {
    for (int r = gw; r < R; r += NGW) {
        int pos, n; if (r < RL) { pos = r & 63; n = 64; } else { pos = (r - RL) & 255; n = 256; }
        const int base = r - pos; const float* mp = modl + (size_t)row_batch(r) * MODW + scale_idx * D;
#pragma unroll
        for (int j = 0; j < 8; ++j) { const int c = 4 * lane + 256 * j, W = 2 << (j >> 1);
            int lo = pos - W / 2; lo = lo < 0 ? 0 : lo; int hi = pos + W - W / 2 - 1; hi = hi > n - 1 ? n - 1 : hi;
            f32x4 a = (f32x4){0.f, 0.f, 0.f, 0.f};
            for (int p = lo; p <= hi; ++p) a += *(const f32x4*)(XZ + (size_t)(base + p) * D + c);
            const f32x4 self = *(const f32x4*)(XZ + (size_t)r * D + c), sc = *(const f32x4*)(mp + c);
            const f32x4 h = (a * (1.0f / (float)(hi - lo + 1)) - self) * (sc + 1.0f);
            u32x2 w; w.x = cvt_pk_bf16(h.x, h.y); w.y = cvt_pk_bf16(h.z, h.w); *(u32x2*)(H + (size_t)r * D + c) = w; }
    }
}
template <int HD>
__device__ __forceinline__ void readout_phase(int gw, int NGW, int lane, const float* O1, const float* O2, const bf16* PROJ, int ldp, int gcol, const float* norm_g, bf16* H) {
    for (int r = gw; r < R; r += NGW) {
#pragma unroll
        for (int j = 0; j < 8; ++j) { const int c = 4 * lane + 256 * j;
            const f32x4 o = *(const f32x4*)(O1 + (size_t)r * D + c) + *(const f32x4*)(O2 + (size_t)r * D + c);
            float s = (o.x * o.x + o.y * o.y) + (o.z * o.z + o.w * o.w);
#pragma unroll
            for (int off = 1; off < (HD == 128 ? 32 : 64); off <<= 1) s += __shfl_xor(s, off);
            const float rs = 1.0f / sqrtf(s * (1.0f / HD) + RMS_EPS);
            const u32x2 gw2 = *(const u32x2*)(PROJ + (size_t)r * ldp + gcol + c); const f32x4 ng = *(const f32x4*)(norm_g + c);
            f32x4 h; h.x = o.x * rs * ng.x * bf_lo(gw2.x); h.y = o.y * rs * ng.y * bf_hi(gw2.x); h.z = o.z * rs * ng.z * bf_lo(gw2.y); h.w = o.w * rs * ng.w * bf_hi(gw2.y);
            u32x2 w; w.x = cvt_pk_bf16(h.x, h.y); w.y = cvt_pk_bf16(h.z, h.w); *(u32x2*)(H + (size_t)r * D + c) = w; }
    }
}
__device__ __forceinline__ void s5_readout_phase(int gw, int NGW, int lane, const float* Y1, const float* Y2, const float* XZ, const float* dskip, const float* modl, int shift_idx, int scale_idx, bf16* H) {
    for (int r = gw; r < R; r += NGW) {
        const float* mp = modl + (size_t)row_batch(r) * MODW;
#pragma unroll
        for (int j = 0; j < 8; ++j) { const int c = 4 * lane + 256 * j;
            const f32x4 x = *(const f32x4*)(XZ + (size_t)r * D + c), sh = *(const f32x4*)(mp + shift_idx * D + c), sc = *(const f32x4*)(mp + scale_idx * D + c), dk = *(const f32x4*)(dskip + c);
            const f32x4 y = *(const f32x4*)(Y1 + (size_t)r * D + c) + *(const f32x4*)(Y2 + (size_t)r * D + c) + dk * (x * (sc + 1.0f) + sh);
            u32x2 w; w.x = cvt_pk_bf16(gelu_tanh(y.x), gelu_tanh(y.y)); w.y = cvt_pk_bf16(gelu_tanh(y.z), gelu_tanh(y.w)); *(u32x2*)(H + (size_t)r * D + c) = w; }
    }
}

__device__ __forceinline__ void hgrn_scan(LAS unsigned char* lds, const bf16* PROJ, float* Of, float* Ob, int tid) {
    constexpr int TB = 16, QS = 144, LDP = 5 * D;
    LAS float* qs = (LAS float*)lds;
    LAS float* ks = qs + 2 * TB * QS;
    LAS float* vs = ks + 2 * TB * QS;
    const int lane = tid & 63, w = tid >> 6, vloc = lane >> 2, kq = lane & 3, v = 16 * w + vloc;
    const int sA = (tid >> 4) & 15, arrA = tid >> 8, chunk = tid & 15;
    for (int seq = blockIdx.x; seq < NB * 16 * 2; seq += gridDim.x) {
        const int d = seq & 1, head = (seq >> 1) & 15, b = seq >> 5;
        float* O = d ? Ob : Of;
        const int colA = (arrA == 0 ? head * 128 : 3 * D + d * D + head * 128) + chunk * 8, colV = D + head * 128 + chunk * 8;
        f32x2 S[16];
#pragma unroll
        for (int j = 0; j < 16; ++j) S[j] = (f32x2){0.f, 0.f};
        u32x4 ra, rv = (u32x4){0u, 0u, 0u, 0u};
        ra = *(const u32x4*)(PROJ + (size_t)scan_row(b, d, sA) * LDP + colA);
        if (tid < 256) rv = *(const u32x4*)(PROJ + (size_t)scan_row(b, d, sA) * LDP + colV);
        __syncthreads();
#define HG_WRITE(buf) do { LAS float* dq = (arrA ? ks : qs) + ((buf) * TB + sA) * QS + chunk * 8 + 4 * (chunk >> 2); \
            *(LAS f32x4*)dq = (f32x4){bf_lo(ra.x), bf_hi(ra.x), bf_lo(ra.y), bf_hi(ra.y)}; *(LAS f32x4*)(dq + 4) = (f32x4){bf_lo(ra.z), bf_hi(ra.z), bf_lo(ra.w), bf_hi(ra.w)}; \
            if (tid < 256) { LAS float* dv = vs + ((buf) * TB + sA) * 128 + chunk * 8; \
                *(LAS f32x4*)dv = (f32x4){bf_lo(rv.x), bf_hi(rv.x), bf_lo(rv.y), bf_hi(rv.y)}; *(LAS f32x4*)(dv + 4) = (f32x4){bf_lo(rv.z), bf_hi(rv.z), bf_lo(rv.w), bf_hi(rv.w)}; } } while (0)
        HG_WRITE(0);
        __syncthreads();
        for (int nb = 0; nb < NSTEP / TB; ++nb) {
            const int buf = nb & 1;
            if (nb + 1 < NSTEP / TB) { const size_t ro = (size_t)scan_row(b, d, (nb + 1) * TB + sA) * LDP; ra = *(const u32x4*)(PROJ + ro + colA); if (tid < 256) rv = *(const u32x4*)(PROJ + ro + colV); }
            for (int s = 0; s < TB; ++s) {
                const LAS f32x4* q4 = (const LAS f32x4*)(qs + (buf * TB + s) * QS + kq * 36);
                const LAS f32x4* k4 = (const LAS f32x4*)(ks + (buf * TB + s) * QS + kq * 36);
                const float vv = vs[(buf * TB + s) * 128 + v];
                f32x2 o2 = (f32x2){0.f, 0.f};
#pragma unroll
                for (int jj = 0; jj < 8; ++jj) { const f32x4 q = q4[jj], k = k4[jj];
                    const f32x2 k01 = (f32x2){k.x, k.y}, k23 = (f32x2){k.z, k.w}, q01 = (f32x2){q.x, q.y}, q23 = (f32x2){q.z, q.w};
                    S[2 * jj] = (1.0f - k01) * S[2 * jj] + k01 * vv; o2 += q01 * S[2 * jj];
                    S[2 * jj + 1] = (1.0f - k23) * S[2 * jj + 1] + k23 * vv; o2 += q23 * S[2 * jj + 1]; }
                float o = o2.x + o2.y; o += __shfl_xor(o, 1); o += __shfl_xor(o, 2);
                if (kq == 0) O[(size_t)scan_row(b, d, nb * TB + s) * D + head * 128 + v] = o;
            }
            if (nb + 1 < NSTEP / TB) HG_WRITE(buf ^ 1);
            __syncthreads();
        }
#undef HG_WRITE
    }
}
__device__ __forceinline__ void mlstm_scan(LAS unsigned char* lds, const bf16* PROJ, const float* gates, float* Hf, float* Hb, int tid) {
    constexpr int TB = 16, QS = 272, LDP = 4 * D;
    LAS float* qs = (LAS float*)lds;
    LAS float* ks = qs + 2 * TB * QS;
    LAS float* vs = ks + 2 * TB * QS;
    LAS float* gs = vs + 2 * TB * 128;
    const int lane = tid & 63, w = tid >> 6, vloc = lane >> 2, kq = lane & 3;
    const int sQ = tid >> 5, chQ = tid & 31, sV = (tid >> 4) & 15, chV = tid & 15, sG = (tid >> 1) & 15, whG = tid & 1;
    for (int seq = blockIdx.x; seq < NB * 8 * 2 * 2; seq += gridDim.x) {
        const int vh = seq & 1, d = (seq >> 1) & 1, head = (seq >> 2) & 7, b = seq >> 5;
        float* Hd = d ? Hb : Hf;
        const int colQ = head * 256 + chQ * 8, colK = D + head * 256 + chQ * 8, colV = 2 * D + head * 256 + vh * 128 + chV * 8, colG = d * 16 + whG * 8 + head;
        f32x2 C[32];
#pragma unroll
        for (int j = 0; j < 32; ++j) C[j] = (f32x2){0.f, 0.f};
        f32x4 n4 = (f32x4){0.f, 0.f, 0.f, 0.f}; float mst = 0.f;
        u32x4 rq, rk, rv = (u32x4){0u, 0u, 0u, 0u}; float rg = 0.f;
        { const size_t ro = (size_t)scan_row(b, d, sQ) * LDP; rq = *(const u32x4*)(PROJ + ro + colQ); rk = *(const u32x4*)(PROJ + ro + colK); }
        if (tid < 256) rv = *(const u32x4*)(PROJ + (size_t)scan_row(b, d, sV) * LDP + colV);
        if (tid < 32) rg = gates[(size_t)scan_row(b, d, sG) * 32 + colG];
        __syncthreads();
#define ML_W8(dst, r) do { *(LAS f32x4*)(dst) = (f32x4){bf_lo(r.x), bf_hi(r.x), bf_lo(r.y), bf_hi(r.y)}; *(LAS f32x4*)((dst) + 4) = (f32x4){bf_lo(r.z), bf_hi(r.z), bf_lo(r.w), bf_hi(r.w)}; } while (0)
#define ML_WRITE(buf) do { ML_W8(qs + ((buf) * TB + sQ) * QS + chQ * 8 + 4 * (chQ >> 3), rq); ML_W8(ks + ((buf) * TB + sQ) * QS + chQ * 8 + 4 * (chQ >> 3), rk); \
            if (tid < 256) ML_W8(vs + ((buf) * TB + sV) * 128 + chV * 8, rv); if (tid < 32) gs[((buf) * TB + sG) * 2 + whG] = rg; } while (0)
        ML_WRITE(0);
        __syncthreads();
        for (int nb = 0; nb < NSTEP / TB; ++nb) {
            const int buf = nb & 1;
            if (nb + 1 < NSTEP / TB) { const int n1 = (nb + 1) * TB; const size_t ro = (size_t)scan_row(b, d, n1 + sQ) * LDP; rq = *(const u32x4*)(PROJ + ro + colQ); rk = *(const u32x4*)(PROJ + ro + colK);
                if (tid < 256) rv = *(const u32x4*)(PROJ + (size_t)scan_row(b, d, n1 + sV) * LDP + colV); if (tid < 32) rg = gates[(size_t)scan_row(b, d, n1 + sG) * 32 + colG]; }
            for (int s = 0; s < TB; ++s) {
                const float logi = gs[(buf * TB + s) * 2], logf = gs[(buf * TB + s) * 2 + 1];
                const float mnew = fmaxf(logf + mst, logi), fd = __expf(logf + mst - mnew), iw = __expf(logi - mnew); mst = mnew;
                const LAS f32x4* q4 = (const LAS f32x4*)(qs + (buf * TB + s) * QS + kq * 68);
                const LAS f32x4* k4 = (const LAS f32x4*)(ks + (buf * TB + s) * QS + kq * 68);
                const float ikv = iw * vs[(buf * TB + s) * 128 + 16 * w + vloc];
                f32x2 o2 = (f32x2){0.f, 0.f};
#pragma unroll
                for (int jj = 0; jj < 16; ++jj) { const f32x4 q = q4[jj], k = k4[jj];
                    const f32x2 k01 = (f32x2){k.x, k.y}, k23 = (f32x2){k.z, k.w}, q01 = (f32x2){q.x, q.y}, q23 = (f32x2){q.z, q.w};
                    C[2 * jj] = fd * C[2 * jj] + k01 * ikv; o2 += q01 * C[2 * jj];
                    C[2 * jj + 1] = fd * C[2 * jj + 1] + k23 * ikv; o2 += q23 * C[2 * jj + 1]; }
                float num = o2.x + o2.y; num += __shfl_xor(num, 1); num += __shfl_xor(num, 2);
                const int po = 4 * lane + 4 * (lane >> 4);
                const f32x4 kn = *(const LAS f32x4*)(ks + (buf * TB + s) * QS + po), qn = *(const LAS f32x4*)(qs + (buf * TB + s) * QS + po);
                n4 = fd * n4 + iw * kn;
                const float den = wave_sum((qn.x * n4.x + qn.y * n4.y) + (qn.z * n4.z + qn.w * n4.w));
                const float hval = num / fmaxf(fabsf(den), __expf(-mst));
                if (kq == 0) Hd[(size_t)scan_row(b, d, nb * TB + s) * D + head * 256 + vh * 128 + 16 * w + vloc] = hval;
            }
            if (nb + 1 < NSTEP / TB) ML_WRITE(buf ^ 1);
            __syncthreads();
        }
#undef ML_WRITE
#undef ML_W8
    }
}
__device__ __forceinline__ void s5_scan(LAS unsigned char* lds, const float* XZ, const float* modl, int shift_idx, int scale_idx,
                                        const float* abar, const float* bbar, const float* cre, const float* cim, float* Yf, float* Yb, int tid) {
    constexpr int TB = 32;
    const int lane = tid & 63, w = tid >> 6;
    LAS float* us = (LAS float*)lds + w * (2 * TB * 16);
    const int sL = lane >> 1, hL = lane & 1;
    for (int seq = blockIdx.x * 8 + w; seq < NB * 128 * 2; seq += gridDim.x * 8) {
        const int d = seq & 1, g = (seq >> 1) & 127, b = seq >> 8;
        float* Y = d ? Yb : Yf;
        const float ar = abar[(d * 128 + g) * 64 + lane], ai = abar[2 * 128 * 64 + (d * 128 + g) * 64 + lane];
        float bbr[16], bbi[16], cr[16], ci[16];
#pragma unroll
        for (int i = 0; i < 16; ++i) { bbr[i] = bbar[((size_t)(d * 128 + g) * 64 + lane) * 16 + i]; bbi[i] = bbar[(size_t)2 * 128 * 64 * 16 + ((size_t)(d * 128 + g) * 64 + lane) * 16 + i];
            cr[i] = cre[((size_t)(d * 128 + g) * 16 + i) * 64 + lane]; ci[i] = cim[((size_t)(d * 128 + g) * 16 + i) * 64 + lane]; }
        const int cL = g * 16 + hL * 8;
        f32x4 sc0, sc1, sh0, sh1, sc0c, sc1c, sh0c, sh1c;
        { const float* mp = modl + (size_t)b * MODW; sc0 = *(const f32x4*)(mp + scale_idx * D + cL) + 1.0f; sc1 = *(const f32x4*)(mp + scale_idx * D + cL + 4) + 1.0f; sh0 = *(const f32x4*)(mp + shift_idx * D + cL); sh1 = *(const f32x4*)(mp + shift_idx * D + cL + 4);
          const float* mc = modl + (size_t)NB * MODW; sc0c = *(const f32x4*)(mc + scale_idx * D + cL) + 1.0f; sc1c = *(const f32x4*)(mc + scale_idx * D + cL + 4) + 1.0f; sh0c = *(const f32x4*)(mc + shift_idx * D + cL); sh1c = *(const f32x4*)(mc + shift_idx * D + cL + 4); }
        float xr = 0.f, xi = 0.f;
        f32x4 r0, r1;
        { const float* p = XZ + (size_t)scan_row(b, d, sL) * D + cL; r0 = *(const f32x4*)p; r1 = *(const f32x4*)(p + 4); }
#define S5_WRITE(buf, isctx) do { LAS float* du = us + ((buf) * TB + sL) * 16 + hL * 8; \
            *(LAS f32x4*)du = (isctx) ? r0 * sc0c + sh0c : r0 * sc0 + sh0; *(LAS f32x4*)(du + 4) = (isctx) ? r1 * sc1c + sh1c : r1 * sc1 + sh1; } while (0)
        S5_WRITE(0, true);
        __builtin_amdgcn_wave_barrier(); asm volatile("s_waitcnt lgkmcnt(0)" ::: "memory");
        for (int nb = 0; nb < NSTEP / TB; ++nb) {
            const int buf = nb & 1;
            if (nb + 1 < NSTEP / TB) { const float* p = XZ + (size_t)scan_row(b, d, (nb + 1) * TB + sL) * D + cL; r0 = *(const f32x4*)p; r1 = *(const f32x4*)(p + 4); }
            for (int s = 0; s < TB; ++s) {
                const LAS f32x4* u4 = (const LAS f32x4*)(us + (buf * TB + s) * 16);
                float bur = 0.f, bui = 0.f;
#pragma unroll
                for (int q = 0; q < 4; ++q) { const f32x4 u = u4[q];
                    bur += bbr[4 * q] * u.x + bbr[4 * q + 1] * u.y + bbr[4 * q + 2] * u.z + bbr[4 * q + 3] * u.w;
                    bui += bbi[4 * q] * u.x + bbi[4 * q + 1] * u.y + bbi[4 * q + 2] * u.z + bbi[4 * q + 3] * u.w; }
                const float nxr = ar * xr - ai * xi + bur, nxi = ar * xi + ai * xr + bui; xr = nxr; xi = nxi;
                float yv[16];
#pragma unroll
                for (int i = 0; i < 16; ++i) yv[i] = cr[i] * xr - ci[i] * xi;
                float r8[8], r4[4], r2[2], r1v;
                { const bool hi = lane & 32;
#pragma unroll
                  for (int j = 0; j < 8; ++j) { const float send = hi ? yv[j] : yv[j + 8], keep = hi ? yv[j + 8] : yv[j]; r8[j] = keep + __shfl_xor(send, 32); } }
                { const bool hi = lane & 16;
#pragma unroll
                  for (int j = 0; j < 4; ++j) { const float send = hi ? r8[j] : r8[j + 4], keep = hi ? r8[j + 4] : r8[j]; r4[j] = keep + __shfl_xor(send, 16); } }
                { const bool hi = lane & 8;
#pragma unroll
                  for (int j = 0; j < 2; ++j) { const float send = hi ? r4[j] : r4[j + 2], keep = hi ? r4[j + 2] : r4[j]; r2[j] = keep + __shfl_xor(send, 8); } }
                { const bool hi = lane & 4; const float send = hi ? r2[0] : r2[1], keep = hi ? r2[1] : r2[0]; r1v = keep + __shfl_xor(send, 4); }
                r1v += __shfl_xor(r1v, 1); r1v += __shfl_xor(r1v, 2);
                const int oi = ((lane >> 5) & 1) * 8 + ((lane >> 4) & 1) * 4 + ((lane >> 3) & 1) * 2 + ((lane >> 2) & 1);
                if ((lane & 3) == 0) Y[(size_t)scan_row(b, d, nb * TB + s) * D + g * 16 + oi] = r1v;
            }
            if (nb + 1 < NSTEP / TB) { const bool isctx = (nb + 1) * TB < CT; S5_WRITE(buf ^ 1, isctx); }
            __builtin_amdgcn_wave_barrier(); asm volatile("s_waitcnt lgkmcnt(0)" ::: "memory");
        }
#undef S5_WRITE
    }
}

struct Args { const float* in[31]; float* out; unsigned char* ws; int ph_lo, ph_hi; };
enum { I_X = 0, I_C, I_CTX, I_CCTX, I_MODW, I_MODB, I_LNG, I_LNB, I_F1W13, I_F1W2, I_F2W13, I_F2W2, I_HGWIN, I_HGLB, I_HGNG, I_HGWO, I_POOLW, I_POOLS,
       I_MLWIN, I_MLGB, I_MLNG, I_MLWO, I_S5LRE, I_S5LIM, I_S5LDT, I_S5BRE, I_S5BIM, I_S5CRE, I_S5CIM, I_S5D, I_S5GLU };

__global__ void __launch_bounds__(512, 2) mega(Args a) {
    extern __shared__ __attribute__((aligned(16))) unsigned char lds_raw[];
    LAS unsigned char* lds = (LAS unsigned char*)lds_raw;
    volatile LAS unsigned* MISC = (volatile LAS unsigned*)(lds + MISC_OFF);
    const int tid = threadIdx.x, lane = tid & 63, wave = __builtin_amdgcn_readfirstlane(tid >> 6);
    const int gw = blockIdx.x * 8 + wave, NGW = gridDim.x * 8;
    unsigned char* ws = a.ws;
    for (int u = tid; u < (LDS_BYTES - RING_BYTES) / 4; u += 512) ((LAS unsigned*)(lds + RING_BYTES))[u] = 0u;
    __syncthreads();
    XcdBarrier bar = xcd_barrier_post((unsigned*)(ws + WS_CTL) + CW_BAR, MISC + 8);
    const int lo = a.ph_lo, hi = a.ph_hi; int ph = 0;
#define PH_BEGIN if (ph >= lo && ph < hi) {
#define PH_END if (ph + 1 < hi) xcd_barrier(bar); } ++ph;

    float* MODV = (float*)(ws + WS_MODV); float* LB = (float*)(ws + WS_LB); float* S5A = (float*)(ws + WS_S5A); float* S5B = (float*)(ws + WS_S5B); float* GATES = (float*)(ws + WS_GATES);
    float* XZ = (float*)(ws + WS_XZ); bf16* H = (bf16*)(ws + WS_H); unsigned char* BIG = ws + WS_BIG;

    PH_BEGIN
    {
        LAS float* s_lds = (LAS float*)lds;
        LAS float* red = s_lds + 9 * D;
        for (int i = tid; i < 9 * D; i += 512) { const float x = i < 8 * D ? a.in[I_C][i] : a.in[I_CCTX][i - 8 * D]; s_lds[i] = fsilu(x); }
        __syncthreads();
        for (int item = blockIdx.x; item < DEPTH * (MODW / 64); item += gridDim.x) {
            const int l = item / (MODW / 64), n0 = (item % (MODW / 64)) * 64;
            const float* wp = a.in[I_MODW] + ((size_t)l * D + wave * 256) * MODW + n0 + lane;
            float acc[9];
#pragma unroll
            for (int j = 0; j < 9; ++j) acc[j] = 0.f;
#pragma unroll 4
            for (int k = 0; k < 256; k += 4) {
                const float w0 = wp[(size_t)k * MODW], w1 = wp[(size_t)(k + 1) * MODW], w2 = wp[(size_t)(k + 2) * MODW], w3 = wp[(size_t)(k + 3) * MODW];
#pragma unroll
                for (int j = 0; j < 9; ++j) { const f32x4 s4 = *(const LAS f32x4*)(s_lds + j * D + wave * 256 + k); acc[j] += (w0 * s4.x + w1 * s4.y) + (w2 * s4.z + w3 * s4.w); }
            }
#pragma unroll
            for (int j = 0; j < 9; ++j) red[(wave * 9 + j) * 64 + lane] = acc[j];
            __syncthreads();
            for (int o = tid; o < 9 * 64; o += 512) { const int j = o >> 6, ln = o & 63; float s = 0.f;
#pragma unroll
                for (int ww = 0; ww < 8; ++ww) s += red[(ww * 9 + j) * 64 + ln];
                MODV[((size_t)l * 9 + j) * MODW + n0 + ln] = s + a.in[I_MODB][(size_t)l * MODW + n0 + ln]; }
            __syncthreads();
        }
        for (int i = blockIdx.x * 512 + tid; i < 2 * D; i += gridDim.x * 512) { const int dd = i / D, c = i % D; const float* lp = a.in[I_HGLB] + (size_t)dd * DEPTH * D + c;
            float mx = lp[0]; for (int j = 1; j < DEPTH; ++j) mx = fmaxf(mx, lp[(size_t)j * D]); float sum = 0.f; for (int j = 0; j < DEPTH; ++j) sum += expf(lp[(size_t)j * D] - mx);
            LB[i] = expf(lp[0] - mx) / sum; }
        for (int i = blockIdx.x * 512 + tid; i < 2 * 128 * 64; i += gridDim.x * 512) { const int dg = i >> 6;
            const double lre = a.in[I_S5LRE][i], lim = a.in[I_S5LIM][i], dt = exp((double)a.in[I_S5LDT][dg]);
            const double mag = exp(lre * dt), abr = mag * cos(lim * dt), abi = mag * sin(lim * dt), den = lre * lre + lim * lim;
            const double nr = abr - 1.0, ni = abi, fr = (nr * lre + ni * lim) / den, fi = (ni * lre - nr * lim) / den;
            S5A[i] = (float)abr; S5A[2 * 128 * 64 + i] = (float)abi;
            for (int q = 0; q < 16; ++q) { const double br = a.in[I_S5BRE][(size_t)i * 16 + q], bi = a.in[I_S5BIM][(size_t)i * 16 + q];
                S5B[(size_t)i * 16 + q] = (float)(fr * br - fi * bi); S5B[(size_t)2 * 128 * 64 * 16 + (size_t)i * 16 + q] = (float)(fr * bi + fi * br); } }
        LAS float* scr = (LAS float*)(lds + wave * 16384);
        constexpr int I_HI = (D / 64) * (5 * D / 32), I_DD = (D / 64) * (D / 32), I_PW = (512 / 64) * (512 / 32), I_MI = (D / 64) * (8224 / 32), I_GL = (D / 64) * (2 * D / 32);
        for (int it = gw; it < I_HI + 2 * I_DD + 4 * I_PW + I_MI + I_GL; it += NGW) {
            int r = it;
            if (r < I_HI) { transpose_item(a.in[I_HGWIN], 5 * D, (bf16*)(ws + WS_HGIN), D, 0, 0, scr, r, lane); continue; } r -= I_HI;
            if (r < I_DD) { transpose_item(a.in[I_HGWO], D, (bf16*)(ws + WS_HGO), D, 0, 0, scr, r, lane); continue; } r -= I_DD;
            if (r < I_DD) { transpose_item(a.in[I_MLWO], D, (bf16*)(ws + WS_MLO), D, 0, 0, scr, r, lane); continue; } r -= I_DD;
            if (r < 4 * I_PW) { const int gq = r / I_PW; transpose_item(a.in[I_POOLW] + (size_t)gq * 512 * 512, 512, (bf16*)(ws + WS_POOLW) + (size_t)gq * 512 * 512, 512, 0, 0, scr, r % I_PW, lane); continue; } r -= 4 * I_PW;
            if (r < I_MI) { transpose_item(a.in[I_MLWIN], 8224, (bf16*)(ws + WS_MLIN), D, 0, 0, scr, r, lane); continue; } r -= I_MI;
            transpose_item(a.in[I_S5GLU], 2 * D, (bf16*)(ws + WS_GLU), D, 1, D, scr, r, lane);
        }
        for (int i = blockIdx.x * 512 + tid; i < (MLN - 8224) * D / 8; i += gridDim.x * 512) ((u32x4*)((bf16*)(ws + WS_MLIN) + (size_t)8224 * D))[i] = (u32x4){0u, 0u, 0u, 0u};
        convert_ffn_layer(a.in[I_F1W13], a.in[I_F1W2], a.in[I_F2W13], a.in[I_F2W2], ws, scr, gw, NGW, lane);
    }
    PH_END

    PH_BEGIN
    row_phase<0>(gw, NGW, lane, R, a.in[I_X], a.in[I_CTX], XZ, H, nullptr, nullptr, MODV, 0, 1, nullptr);
    PH_END

#define LAYER_BODY(l) { \
        const float* modl = MODV + (size_t)l * 9 * MODW; \
        const float* lng = a.in[I_LNG] + (size_t)l * 3 * D; const float* lnb = a.in[I_LNB] + (size_t)l * 3 * D; \
        PH_BEGIN { pg8::Gemm g{H, (const bf16*)(ws + WS_W13A), R, 2 * FF, D, D, D, 0}; EpiSwiglu E{(bf16*)BIG}; pg8::gemm_phase(lds, g, E); } PH_END \
        PH_BEGIN { pg8::Gemm g{(const bf16*)BIG, (const bf16*)(ws + WS_W2A), R, D, FF, FF, FF, 0}; EpiResid E{XZ, modl, 2, 0.5f, nullptr}; pg8::gemm_phase(lds, g, E); } PH_END \
        PH_BEGIN row_phase<1>(gw, NGW, lane, R, nullptr, nullptr, XZ, H, lng, lnb, modl, 3, 4, nullptr); PH_END \
        const int MR = (l == DEPTH - 1) ? RL : R; \
        if (l == 0) { \
            PH_BEGIN { pg8::Gemm g{H, (const bf16*)(ws + WS_HGIN), R, 5 * D, D, D, D, 0}; EpiHgIn E{(bf16*)BIG, LB}; pg8::gemm_phase(lds, g, E); } PH_END \
            PH_BEGIN hgrn_scan(lds, (const bf16*)BIG, (float*)(BIG + BIG_O1_HG), (float*)(BIG + BIG_O2_HG), tid); PH_END \
            PH_BEGIN readout_phase<128>(gw, NGW, lane, (const float*)(BIG + BIG_O1_HG), (const float*)(BIG + BIG_O2_HG), (const bf16*)BIG, 5 * D, 2 * D, a.in[I_HGNG], H); PH_END \
            PH_BEGIN { pg8::Gemm g{H, (const bf16*)(ws + WS_HGO), MR, D, D, D, D, 0}; EpiResid E{XZ, modl, 5, 1.0f, nullptr}; pg8::gemm_phase(lds, g, E); } PH_END \
        } \
        if (l == 1) { \
            PH_BEGIN pool_phase(gw, NGW, lane, XZ, H, modl, 4); PH_END \
            PH_BEGIN { pg8::Gemm g{H, (const bf16*)(ws + WS_POOLW), MR, D, 512, D, 512, 2}; EpiResid E{XZ, modl, 5, 1.0f, a.in[I_POOLS]}; pg8::gemm_phase(lds, g, E); } PH_END \
        } \
        if (l == 2) { \
            PH_BEGIN { pg8::Gemm g{H, (const bf16*)(ws + WS_MLIN), R, MLN, D, D, D, 0}; EpiMlIn E{(bf16*)BIG, GATES, a.in[I_MLGB]}; pg8::gemm_phase(lds, g, E); } PH_END \
            PH_BEGIN mlstm_scan(lds, (const bf16*)BIG, GATES, (float*)(BIG + BIG_O1_ML), (float*)(BIG + BIG_O2_ML), tid); PH_END \
            PH_BEGIN readout_phase<256>(gw, NGW, lane, (const float*)(BIG + BIG_O1_ML), (const float*)(BIG + BIG_O2_ML), (const bf16*)BIG, 4 * D, 3 * D, a.in[I_MLNG], H); PH_END \
            PH_BEGIN { pg8::Gemm g{H, (const bf16*)(ws + WS_MLO), MR, D, D, D, D, 0}; EpiResid E{XZ, modl, 5, 1.0f, nullptr}; pg8::gemm_phase(lds, g, E); } PH_END \
        } \
        if (l == 3) { \
            PH_BEGIN s5_scan(lds, XZ, modl, 3, 4, S5A, S5B, a.in[I_S5CRE], a.in[I_S5CIM], (float*)(BIG + BIG_O1_S5), (float*)(BIG + BIG_O2_S5), tid); PH_END \
            PH_BEGIN s5_readout_phase(gw, NGW, lane, (const float*)(BIG + BIG_O1_S5), (const float*)(BIG + BIG_O2_S5), XZ, a.in[I_S5D], modl, 3, 4, H); PH_END \
            PH_BEGIN { pg8::Gemm g{H, (const bf16*)(ws + WS_GLU), MR, 2 * D, D, D, D, 0}; EpiS5Glu E{XZ, modl, 5}; pg8::gemm_phase(lds, g, E); } PH_END \
        } \
        PH_BEGIN row_phase<1>(gw, NGW, lane, MR, nullptr, nullptr, XZ, H, lng + D, lnb + D, modl, 6, 7, nullptr); PH_END \
        PH_BEGIN { pg8::Gemm g{H, (const bf16*)(ws + WS_W13B), MR, 2 * FF, D, D, D, 0}; EpiSwiglu E{(bf16*)BIG}; pg8::gemm_phase(lds, g, E); } PH_END \
        PH_BEGIN { pg8::Gemm g{(const bf16*)BIG, (const bf16*)(ws + WS_W2B), MR, D, FF, FF, FF, 0}; EpiResid E{XZ, modl, 8, 0.5f, nullptr}; pg8::gemm_phase(lds, g, E); } PH_END \
        PH_BEGIN \
        if (l + 1 < DEPTH) { \
            row_phase<1>(gw, NGW, lane, R, nullptr, nullptr, XZ, H, lng + 2 * D, lnb + 2 * D, modl + (size_t)9 * MODW, 0, 1, nullptr); \
            const size_t o13 = (size_t)(l + 1) * D * 2 * FF, o2 = (size_t)(l + 1) * FF * D; \
            convert_ffn_layer(a.in[I_F1W13] + o13, a.in[I_F1W2] + o2, a.in[I_F2W13] + o13, a.in[I_F2W2] + o2, ws, (LAS float*)(lds + wave * 16384), gw, NGW, lane); \
        } else { \
            row_phase<1>(gw, NGW, lane, RL, nullptr, nullptr, XZ, nullptr, lng + 2 * D, lnb + 2 * D, modl, 0, 1, a.out); \
        } \
        PH_END \
    }
    LAYER_BODY(0) LAYER_BODY(1) LAYER_BODY(2) LAYER_BODY(3)
#undef LAYER_BODY
#undef PH_BEGIN
#undef PH_END
}

static int n_phases() { int n = 2; for (int l = 0; l < DEPTH; ++l) { n += 3; n += (l == 0 || l == 2) ? 4 : (l == 1 ? 2 : 3); n += 1 + 3; } return n; }

extern "C" void kernel_launch(void* const* d_in, const int* in_sizes, int n_in, void* d_out, int out_size, void* d_ws, size_t ws_size, hipStream_t stream) {
    static int grid = 0;
    if (grid == 0) {
        if (n_in != 31 || in_sizes[0] != RL * D || out_size != RL * D || ws_size < WS_END) {
            fprintf(stderr, "kernel_launch: unexpected problem: n_in %d in0 %d out %d ws %zu (need %zu)\n", n_in, n_in > 0 ? in_sizes[0] : -1, out_size, ws_size, (size_t)WS_END); grid = -1; return; }
        int dev = 0, cus = 0, per_cu = 0;
        if (hipGetDevice(&dev) != hipSuccess || hipDeviceGetAttribute(&cus, hipDeviceAttributeMultiprocessorCount, dev) != hipSuccess) { grid = -1; return; }
        if (hipFuncSetAttribute((const void*)mega, hipFuncAttributeMaxDynamicSharedMemorySize, LDS_BYTES) != hipSuccess) { fprintf(stderr, "kernel_launch: hipFuncSetAttribute failed\n"); grid = -1; return; }
        if (hipOccupancyMaxActiveBlocksPerMultiprocessor(&per_cu, (const void*)mega, 512, LDS_BYTES) != hipSuccess || per_cu < 1) fprintf(stderr, "kernel_launch: occupancy query reports %d\n", per_cu);
        (void)hipGetLastError();
        grid = cus;
    }
    if (grid < 0) return;
    (void)hipMemsetAsync((char*)d_ws + WS_CTL, 0, CTL_BYTES, stream);
    Args a{};
    for (int i = 0; i < 31; ++i) a.in[i] = (const float*)d_in[i];
    a.out = (float*)d_out; a.ws = (unsigned char*)d_ws;
    const int NPH = n_phases();
#if MK_MULTI
    for (int p = 0; p < NPH; ++p) { a.ph_lo = p; a.ph_hi = p + 1; hipLaunchKernelGGL(mega, dim3(grid), dim3(512), LDS_BYTES, stream, a); }
#else
    a.ph_lo = 0; a.ph_hi = NPH; hipLaunchKernelGGL(mega, dim3(grid), dim3(512), LDS_BYTES, stream, a);
#endif
}
```

```cpp
#include <hip/hip_runtime.h>
#include <cstdio>
#include <cstdint>

#ifndef MK_MULTI
#define MK_MULTI 0
#endif

#ifndef PROBE_DUP
#define PROBE_DUP 0
#endif
#define LAS __attribute__((address_space(3)))
typedef unsigned short bf16;
typedef short bf16x8 __attribute__((ext_vector_type(8)));
typedef float f32x4 __attribute__((ext_vector_type(4)));
typedef float f32x2 __attribute__((ext_vector_type(2)));
typedef unsigned u32x4 __attribute__((ext_vector_type(4)));
typedef unsigned u32x2 __attribute__((ext_vector_type(2)));

constexpr int D = 2048, NB = 8, T = 4096, CT = 256, DEPTH = 4, FF = 5632, NMOD = 9;
constexpr int RL = NB * T;
constexpr int RC = NB * CT;
constexpr int R = RL + RC;
constexpr int MODW = NMOD * D;
constexpr float DN_ALPHA = 1.6817928305074290f;
constexpr float LN_EPS = 1e-5f, RMS_EPS = 1e-6f;
constexpr int MLN = 8448;

constexpr size_t MiB = 1u << 20;
constexpr size_t WS_CTL = 0, CTL_BYTES = 1 * MiB;
constexpr size_t WS_MODV = 1 * MiB;
constexpr size_t WS_LB = 4 * MiB;
constexpr size_t WS_S5A = 5 * MiB;
constexpr size_t WS_S5B = 6 * MiB;
constexpr size_t WS_GATES = 8 * MiB;
constexpr size_t WS_HGIN = 17 * MiB;
constexpr size_t WS_HGO = 57 * MiB;
constexpr size_t WS_POOLW = 65 * MiB;
constexpr size_t WS_MLIN = 67 * MiB;
constexpr size_t WS_MLO = 100 * MiB;
constexpr size_t WS_GLU = 108 * MiB;
constexpr size_t WS_W13A = 124 * MiB, WS_W2A = 168 * MiB, WS_W13B = 190 * MiB, WS_W2B = 234 * MiB;
constexpr size_t WS_XZ = 256 * MiB;
constexpr size_t WS_H = 528 * MiB;
constexpr size_t WS_BIG = 664 * MiB;
constexpr size_t WS_END = (664 + 1224) * MiB;
constexpr size_t BIG_O1_HG = 680 * MiB, BIG_O2_HG = 952 * MiB;
constexpr size_t BIG_O1_ML = 544 * MiB, BIG_O2_ML = 816 * MiB;
constexpr size_t BIG_O1_S5 = 0, BIG_O2_S5 = 272 * MiB;
constexpr int CW_BAR = 4096;

constexpr int RING_BYTES = 131072, MISC_OFF = RING_BYTES + 320, LDS_BYTES = 147456;

__device__ __forceinline__ float bf_lo(unsigned w) { return __uint_as_float(w << 16); }
__device__ __forceinline__ float bf_hi(unsigned w) { return __uint_as_float(w & 0xffff0000u); }
__device__ __forceinline__ unsigned cvt_pk_bf16(float lo, float hi) { unsigned r; asm volatile("v_cvt_pk_bf16_f32 %0, %1, %2" : "=v"(r) : "v"(lo), "v"(hi)); return r; }
__device__ __forceinline__ float fsigmoid(float x) { return __builtin_amdgcn_rcpf(1.0f + __expf(-x)); }
__device__ __forceinline__ float fsilu(float x) { return x * fsigmoid(x); }
__device__ __forceinline__ float gelu_tanh(float x) { const float u = 1.5957691216057308f * (x + 0.044715f * x * x * x); return x * fsigmoid(u); }
__device__ __forceinline__ float wave_sum(float v) {
#pragma unroll
    for (int o = 1; o < 64; o <<= 1) v += __shfl_xor(v, o);
    return v;
}
__device__ __forceinline__ int row_batch(int r) { return r < RL ? (r >> 12) : NB; }
__device__ __forceinline__ int scan_row(int b, int d, int n) {
    if (n < CT) return RL + b * CT + (d ? CT - 1 - n : n);
    const int m = n - CT; return b * T + (d ? T - 1 - m : m);
}
constexpr int NSTEP = CT + T;

#define XB_TMO      128
#define XB_XCNT(j)  (256  + 64 * (j))
#define XB_XSUB(j)  (1280 + 64 * (j))
#define XB_XGEN(j)  (2304 + 64 * (j))
#define XB_TOP      3328
#define XB_TOPGEN   3392
#define XCD_BAR_WORDS 3456
#define XB_SPIN_CAP (1u << 18)
__device__ __forceinline__ unsigned xb_ld(unsigned* p)              { return __hip_atomic_load(p, __ATOMIC_RELAXED, __HIP_MEMORY_SCOPE_AGENT); }
__device__ __forceinline__ unsigned xb_add(unsigned* p, unsigned v) { return __hip_atomic_fetch_add(p, v, __ATOMIC_RELAXED, __HIP_MEMORY_SCOPE_AGENT); }
__device__ __forceinline__ unsigned xb_xcc_id() { return (unsigned)__builtin_amdgcn_s_getreg((3 << 11) | 20) & 0xFu; }
#define XB_SPIN(cond, bar) do { unsigned _sp = 0; while (cond) { __builtin_amdgcn_s_sleep(1); \
    if ((++_sp & 255u) == 0u) { if (xb_ld(&(bar)[XB_TMO])) break; if (_sp > XB_SPIN_CAP) { atomicAdd(&(bar)[XB_TMO], 1u); break; } } } } while (0)
struct XcdBarrier { unsigned* bar; unsigned x; volatile LAS unsigned* st; };
__device__ __forceinline__ XcdBarrier xcd_barrier_post(unsigned* bar, volatile LAS unsigned* st) {
    XcdBarrier b; b.bar = bar; b.x = xb_xcc_id(); b.st = st;
    if (threadIdx.x == 0) (void)xb_add(&bar[XB_XCNT(b.x)], 1u);
    return b;
}
__device__ __forceinline__ void xcd_barrier_complete(unsigned* bar, unsigned x, unsigned& nloc, unsigned& nx) {
    const unsigned G = gridDim.x * gridDim.y * gridDim.z;
    unsigned sum, cnt, mine, sp = 0u;
    for (;;) {
        sum = 0u; cnt = 0u; mine = 0u;
#pragma unroll
        for (unsigned j = 0; j < 16; ++j) { const unsigned c = xb_ld(&bar[XB_XCNT(j)]); sum += c; cnt += (c > 0u) ? 1u : 0u; mine = (j == x) ? c : mine; }
        if (sum == G) break;
        __builtin_amdgcn_s_sleep(1);
        if ((++sp & 255u) == 0u) { if (xb_ld(&bar[XB_TMO])) break; if (sp > XB_SPIN_CAP) { atomicAdd(&bar[XB_TMO], 1u); break; } }
    }
    nloc = mine > 0u ? mine : 1u; nx = cnt > 0u ? cnt : 1u;
}
__device__ __forceinline__ void xcd_barrier(const XcdBarrier& b) {
    asm volatile("s_waitcnt vmcnt(0)" ::: "memory");
    __syncthreads();
    if (threadIdx.x == 0) {
        unsigned* bar = b.bar;
        __builtin_amdgcn_s_waitcnt(0);
        unsigned nloc = b.st[0], nx = b.st[1];
        if (nloc == 0u) { xcd_barrier_complete(bar, b.x, nloc, nx); b.st[0] = nloc; b.st[1] = nx; }
        const unsigned old = xb_add(&bar[XB_XSUB(b.x)], 1u);
        const unsigned gen = old / nloc;
        if (old + 1u == (gen + 1u) * nloc) {
            __builtin_amdgcn_fence(__ATOMIC_RELEASE, "agent");
            asm volatile("s_waitcnt vmcnt(0)" ::: "memory");
            const unsigned og = xb_add(&bar[XB_TOP], 1u);
            const unsigned tg = og / nx;
            if (og + 1u == (tg + 1u) * nx) xb_add(&bar[XB_TOPGEN], 1u);
            else XB_SPIN(xb_ld(&bar[XB_TOPGEN]) == tg, bar);
            __builtin_amdgcn_fence(__ATOMIC_ACQUIRE, "agent");
            xb_add(&bar[XB_XGEN(b.x)], 1u);
            asm volatile("s_waitcnt vmcnt(0)" ::: "memory");
        } else {
            XB_SPIN(xb_ld(&bar[XB_XGEN(b.x)]) == gen, bar);
            __builtin_amdgcn_fence(__ATOMIC_ACQUIRE, "agent");
            asm volatile("s_waitcnt vmcnt(0)" ::: "memory");
        }
    }
    __syncthreads();
}

namespace pg8 {
constexpr int BM = 256, BK = 64, HALF = 128, HTB = HALF * BK * 2, STAGE_BYTES = 8 * HTB, NXCD = 8, WGM = 8;
__host__ __device__ __forceinline__ int lds_byte(int r, int c) { const int st = (r >> 4) * 2 + (c >> 5), rr = r & 15, cc = c & 31, ob = rr * 64 + cc * 2; return st * 1024 + (ob ^ (((ob >> 9) & 1) << 5)); }
__host__ __device__ __forceinline__ void stage_rc(int b, int& Rr, int& C) { const int st = b / 1024, sb = b % 1024, swz = sb ^ (((sb >> 9) & 1) << 5); Rr = (st >> 1) * 16 + swz / 64; C = (st & 1) * 32 + (swz % 64) / 2; }
__host__ __device__ __forceinline__ int perm32(int rho) { const int n = rho >> 4, i = rho & 15; return 8 * (i >> 2) + 4 * n + (i & 3); }
struct Unit { int pm, pn; };
struct Gemm { const bf16* A; const bf16* Bt; int M, N, K, lda, ldb, agrp; };
struct StaticOrder {
    int nM, nN, nwg, G, c;
    __device__ void init(int M, int N, int G_, int c_) { nM = M / BM; nN = N / BM; nwg = nM * nN; G = G_; c = c_; }
    __device__ bool next(int i, Unit& u) const {
        const long L = (long)i * G + c; if (L >= nwg) return false;
        int wgid = (int)L; { const int q = nwg / NXCD, r = nwg % NXCD, xcd = wgid % NXCD, off = wgid / NXCD; wgid = (xcd < r ? xcd * (q + 1) : r * (q + 1) + (xcd - r) * q) + off; }
        const int nig = WGM * nN, gid = wgid / nig, fm = gid * WGM, gsz = (nM - fm) < WGM ? (nM - fm) : WGM;
        u.pm = fm + ((wgid % nig) % gsz); u.pn = (wgid % nig) / gsz; return true;
    }
};
template <class Epi>
__device__ __forceinline__ void gemm_phase(LAS unsigned char* lds, const Gemm g, const Epi& E) {
    const int tid = threadIdx.x, wid = __builtin_amdgcn_readfirstlane(tid >> 6), lane = tid & 63, wr = wid >> 2, wc = wid & 3, fr = lane & 15, fq = lane >> 4;
    const int K = g.K, nt = K / BK;
    StaticOrder S; S.init(g.M, g.N, (int)gridDim.x, (int)blockIdx.x);
    unsigned voffA[2], voffB[2];
#pragma unroll
    for (int i = 0; i < 2; ++i) { int Rr, C; stage_rc(tid * 16 + i * 8192, Rr, C); const int Rb = Epi::PERM ? ((Rr & ~31) + perm32(Rr & 31)) : Rr;
        voffA[i] = (unsigned)(Rr * g.lda + C) * 2u; voffB[i] = (unsigned)(Rb * g.ldb + C) * 2u; }
    const size_t kstep = (size_t)(BK * 2);
    const size_t hstepA = (size_t)HALF * g.lda * 2, hstepB = (size_t)HALF * g.ldb * 2;
    const size_t tstepA = 2 * hstepA, tstepB = 2 * hstepB;
    const unsigned ldsw = (unsigned)wid * 1024u;
    const int aoff = lds_byte(wr * 64 + fr, fq * 8), boff = lds_byte(wc * 32 + fr, fq * 8);
#define PG8_ABASE(u) ((const char*)g.A + (size_t)(u).pm * tstepA + (g.agrp ? (size_t)((u).pn / g.agrp) * (size_t)K * 2 : (size_t)0))
#define PG8_BBASE(u) ((const char*)g.Bt + (size_t)(u).pn * tstepB)
#define PG8_SA(b, h) (((b) * 2 + (h)) * HTB)
#define PG8_SB(b, h) ((4 + (b) * 2 + (h)) * HTB)
#define PG8_STAGE(bufoff, gbase, voff) do { _Pragma("unroll") for (int _i = 0; _i < 2; ++_i) \
        __builtin_amdgcn_global_load_lds((const unsigned*)((const char*)(gbase) + (voff)[_i]), (LAS unsigned*)(lds + (bufoff) + ldsw + _i * 8192), 16, 0, 0); } while (0)
#define PG8_LDA(dst, b, h) do { _Pragma("unroll") for (int m = 0; m < 4; ++m) _Pragma("unroll") for (int k = 0; k < 2; ++k) dst[m][k] = *(const LAS bf16x8*)(lds + PG8_SA(b, h) + aoff + m * 2048 + k * 1024); } while (0)
#define PG8_LDB(dst, b, h) do { _Pragma("unroll") for (int n = 0; n < 2; ++n) _Pragma("unroll") for (int k = 0; k < 2; ++k) dst[n][k] = *(const LAS bf16x8*)(lds + PG8_SB(b, h) + boff + n * 2048 + k * 1024); } while (0)
#define PG8_MMA(ai, bj, At, Bt) do { __builtin_amdgcn_s_setprio(1); _Pragma("unroll") for (int m = 0; m < 4; ++m) _Pragma("unroll") for (int n = 0; n < 2; ++n) _Pragma("unroll") for (int k = 0; k < 2; ++k) \
        acc[ai][bj][m][n] = __builtin_amdgcn_mfma_f32_16x16x32_bf16(Bt[n][k], At[m][k], acc[ai][bj][m][n], 0, 0, 0); __builtin_amdgcn_s_setprio(0); } while (0)
#define PG8_WAIT_V(n) asm volatile("s_waitcnt vmcnt(" #n ")" ::: "memory")
#define PG8_WAIT_L(n) asm volatile("s_waitcnt lgkmcnt(" #n ")" ::: "memory")
#define PG8_BAR __builtin_amdgcn_s_barrier()
#define PG8_SCHED __builtin_amdgcn_sched_barrier(0)
    Unit cur, nxt; int ui = 0;
    if (!S.next(0, cur)) return;
    f32x4 acc[2][2][4][2];
#pragma unroll
    for (int a = 0; a < 2; ++a)
#pragma unroll
        for (int b = 0; b < 2; ++b)
#pragma unroll
            for (int m = 0; m < 4; ++m)
#pragma unroll
                for (int n = 0; n < 2; ++n) acc[a][b][m][n] = (f32x4){0.f, 0.f, 0.f, 0.f};
    bf16x8 At[4][2], B0[2][2], B1[2][2];
    const char* cA = PG8_ABASE(cur); const char* cB = PG8_BBASE(cur);
    PG8_STAGE(PG8_SB(0, 0), cB, voffB); PG8_STAGE(PG8_SB(0, 1), cB + hstepB, voffB); PG8_STAGE(PG8_SA(0, 0), cA, voffA); PG8_STAGE(PG8_SA(0, 1), cA + hstepA, voffA);
    if (wr == 1) PG8_BAR;
    PG8_WAIT_V(2); PG8_BAR;
    PG8_STAGE(PG8_SB(1, 0), cB + kstep, voffB); PG8_STAGE(PG8_SA(1, 0), cA + kstep, voffA); PG8_STAGE(PG8_SB(1, 1), cB + hstepB + kstep, voffB);
    PG8_WAIT_V(6); PG8_BAR;
    for (;;) {
        const bool has_next = S.next(ui + 1, nxt);
        const char* nA = has_next ? PG8_ABASE(nxt) : cA; const char* nB = has_next ? PG8_BBASE(nxt) : cB;
        for (int t = 0; t < nt; t += 2) {
            const bool last = (t == nt - 2);
            const char* a1 = cA + (size_t)(t + 1) * kstep;
            const char* a2 = last ? nA : cA + (size_t)(t + 2) * kstep; const char* b2 = last ? nB : cB + (size_t)(t + 2) * kstep;
            const char* a3 = a2 + kstep; const char* b3 = b2 + kstep;
            PG8_LDB(B0, 0, 0); PG8_LDB(B1, 0, 1); PG8_SCHED; PG8_LDA(At, 0, 0); PG8_STAGE(PG8_SA(1, 1), a1 + hstepA, voffA);
            PG8_WAIT_V(8); PG8_WAIT_L(0); PG8_BAR; PG8_MMA(0, 0, At, B0); PG8_MMA(0, 1, At, B1); PG8_BAR; PG8_SCHED;
            PG8_LDA(At, 0, 1); PG8_STAGE(PG8_SB(0, 0), b2, voffB); PG8_STAGE(PG8_SB(0, 1), b2 + hstepB, voffB); PG8_STAGE(PG8_SA(0, 0), a2, voffA);
            PG8_WAIT_V(8); PG8_WAIT_L(0); PG8_BAR; PG8_MMA(1, 0, At, B0); PG8_MMA(1, 1, At, B1); PG8_BAR; PG8_SCHED;
            PG8_LDB(B0, 1, 0); PG8_LDB(B1, 1, 1); PG8_SCHED; PG8_LDA(At, 1, 0); PG8_STAGE(PG8_SA(0, 1), a2 + hstepA, voffA);
            PG8_WAIT_V(8); PG8_WAIT_L(0); PG8_BAR; PG8_MMA(0, 0, At, B0); PG8_MMA(0, 1, At, B1); PG8_BAR; PG8_SCHED;
            PG8_LDA(At, 1, 1); PG8_STAGE(PG8_SB(1, 0), b3, voffB); PG8_STAGE(PG8_SB(1, 1), b3 + hstepB, voffB); PG8_STAGE(PG8_SA(1, 0), a3, voffA);
            PG8_WAIT_V(8); PG8_WAIT_L(0); PG8_BAR; PG8_MMA(1, 0, At, B0); PG8_MMA(1, 1, At, B1); PG8_BAR; PG8_SCHED;
        }
        if (wr == 0) PG8_BAR;
        E(acc, cur, wr, wc, fr, fq);
        if (!has_next) break;
#pragma unroll
        for (int a = 0; a < 2; ++a)
#pragma unroll
            for (int b = 0; b < 2; ++b)
#pragma unroll
                for (int m = 0; m < 4; ++m)
#pragma unroll
                    for (int n = 0; n < 2; ++n) acc[a][b][m][n] = (f32x4){0.f, 0.f, 0.f, 0.f};
        cur = nxt; cA = nA; cB = nB; ++ui;
        if (wr == 1) PG8_BAR;
    }
    PG8_WAIT_V(0);
    PG8_BAR;
#undef PG8_ABASE
#undef PG8_BBASE
#undef PG8_SA
#undef PG8_SB
#undef PG8_STAGE
#undef PG8_LDA
#undef PG8_LDB
#undef PG8_MMA
#undef PG8_WAIT_V
#undef PG8_WAIT_L
#undef PG8_BAR
#undef PG8_SCHED
}
}
using pg8::Unit; using pg8::HALF; using pg8::BM;
typedef f32x4 Acc[2][2][4][2];

struct EpiSwiglu {
    static constexpr bool PERM = true;
    bf16* O;
    __device__ __forceinline__ void operator()(const Acc& acc, const Unit& u, int wr, int wc, int fr, int fq) const {
        const int row0 = u.pm * BM + wr * 64 + fr, col0 = u.pn * HALF + wc * 32 + 8 * fq;
#pragma unroll
        for (int ai = 0; ai < 2; ++ai)
#pragma unroll
            for (int m = 0; m < 4; ++m) {
                float h[8];
#pragma unroll
                for (int n = 0; n < 2; ++n)
#pragma unroll
                    for (int j = 0; j < 4; ++j) { const float a = acc[ai][0][m][n][j], b = acc[ai][1][m][n][j]; h[4 * n + j] = fsilu(a) * b; }
                u32x4 w; w.x = cvt_pk_bf16(h[0], h[1]); w.y = cvt_pk_bf16(h[2], h[3]); w.z = cvt_pk_bf16(h[4], h[5]); w.w = cvt_pk_bf16(h[6], h[7]);
                *(u32x4*)(O + (size_t)(row0 + ai * HALF + m * 16) * FF + col0) = w;
            }
    }
};
struct EpiResid {
    static constexpr bool PERM = false;
    float* XZ; const float* modl; int gate_idx; float fac; const float* colscale;
    __device__ __forceinline__ void operator()(const Acc& acc, const Unit& u, int wr, int wc, int fr, int fq) const {
        const int row0 = u.pm * BM + wr * 64 + fr, col0 = u.pn * BM + wc * 32 + 4 * fq;
        const float* gp = modl + (size_t)(u.pm < RL / 256 ? (u.pm >> 4) : NB) * MODW + gate_idx * D;
        f32x4 gv[2][2];
#pragma unroll
        for (int bj = 0; bj < 2; ++bj)
#pragma unroll
            for (int n = 0; n < 2; ++n) { const int c = col0 + bj * HALF + n * 16; gv[bj][n] = *(const f32x4*)(gp + c) * fac; if (colscale) gv[bj][n] *= *(const f32x4*)(colscale + c); }
#pragma unroll
        for (int ai = 0; ai < 2; ++ai)
#pragma unroll
            for (int m = 0; m < 4; ++m) { float* rowp = XZ + (size_t)(row0 + ai * HALF + m * 16) * D + col0;
#pragma unroll
                for (int bj = 0; bj < 2; ++bj)
#pragma unroll
                    for (int n = 0; n < 2; ++n) { f32x4* p = (f32x4*)(rowp + bj * HALF + n * 16); const f32x4 x = *p; *p = x * DN_ALPHA + gv[bj][n] * acc[ai][bj][m][n]; }
                asm volatile("" ::: "memory"); }
    }
};
struct EpiHgIn {
    static constexpr bool PERM = true;
    bf16* O; const float* lb;
    __device__ __forceinline__ void operator()(const Acc& acc, const Unit& u, int wr, int wc, int fr, int fq) const {
        const int row0 = u.pm * BM + wr * 64 + fr, col0 = u.pn * BM + wc * 32 + 8 * fq, type = u.pn >> 3;
        float om[2][8];
        if (type >= 3) {
#pragma unroll
            for (int bj = 0; bj < 2; ++bj)
#pragma unroll
                for (int j = 0; j < 8; ++j) om[bj][j] = 1.0f - lb[(type - 3) * D + (col0 + bj * HALF + j - (3 + (type - 3)) * D)];
        }
#pragma unroll
        for (int ai = 0; ai < 2; ++ai)
#pragma unroll
            for (int m = 0; m < 4; ++m) { bf16* rowp = O + (size_t)(row0 + ai * HALF + m * 16) * (5 * D) + col0;
#pragma unroll
                for (int bj = 0; bj < 2; ++bj) { float v[8];
#pragma unroll
                    for (int n = 0; n < 2; ++n)
#pragma unroll
                        for (int j = 0; j < 4; ++j) { const float z = acc[ai][bj][m][n][j]; float o;
                            if (type == 0 || type == 2) o = fsilu(z); else if (type == 1) o = z; else o = om[bj][4 * n + j] * fsigmoid(-z);
                            v[4 * n + j] = o; }
                    u32x4 w; w.x = cvt_pk_bf16(v[0], v[1]); w.y = cvt_pk_bf16(v[2], v[3]); w.z = cvt_pk_bf16(v[4], v[5]); w.w = cvt_pk_bf16(v[6], v[7]);
                    *(u32x4*)(rowp + bj * HALF) = w; } }
    }
};
struct EpiMlIn {
    static constexpr bool PERM = true;
    bf16* O; float* gates; const float* gate_b;
    __device__ __forceinline__ void operator()(const Acc& acc, const Unit& u, int wr, int wc, int fr, int fq) const {
        const int row0 = u.pm * BM + wr * 64 + fr, type = u.pn >> 3;
        if (type < 4) {
            const int col0 = u.pn * BM + wc * 32 + 8 * fq;
#pragma unroll
            for (int ai = 0; ai < 2; ++ai)
#pragma unroll
                for (int m = 0; m < 4; ++m) { bf16* rowp = O + (size_t)(row0 + ai * HALF + m * 16) * (4 * D) + col0;
#pragma unroll
                    for (int bj = 0; bj < 2; ++bj) { float v[8];
#pragma unroll
                        for (int n = 0; n < 2; ++n)
#pragma unroll
                            for (int j = 0; j < 4; ++j) { const float z = acc[ai][bj][m][n][j]; v[4 * n + j] = type == 1 ? z * 0.0625f : (type == 3 ? fsigmoid(z) : z); }
                        u32x4 w; w.x = cvt_pk_bf16(v[0], v[1]); w.y = cvt_pk_bf16(v[2], v[3]); w.z = cvt_pk_bf16(v[4], v[5]); w.w = cvt_pk_bf16(v[6], v[7]);
                        *(u32x4*)(rowp + bj * HALF) = w; } }
        } else if (wc == 0) {
            float gb[8];
#pragma unroll
            for (int j = 0; j < 8; ++j) gb[j] = gate_b[8 * fq + j];
#pragma unroll
            for (int ai = 0; ai < 2; ++ai)
#pragma unroll
                for (int m = 0; m < 4; ++m) { float* gp = gates + (size_t)(row0 + ai * HALF + m * 16) * 32 + 8 * fq;
#pragma unroll
                    for (int n = 0; n < 2; ++n) { f32x4 o;
#pragma unroll
                        for (int j = 0; j < 4; ++j) { float z = acc[ai][0][m][n][j] + gb[4 * n + j];
                            if (fq & 1) z = fminf(z, 0.f) - log1pf(expf(-fabsf(z)));
                            o[j] = z; }
                        *(f32x4*)(gp + 4 * n) = o; } }
        }
    }
};
struct EpiS5Glu {
    static constexpr bool PERM = true;
    float* XZ; const float* modl; int gate_idx;
    __device__ __forceinline__ void operator()(const Acc& acc, const Unit& u, int wr, int wc, int fr, int fq) const {
        const int row0 = u.pm * BM + wr * 64 + fr, col0 = u.pn * HALF + wc * 32 + 8 * fq;
        const float* gp = modl + (size_t)(u.pm < RL / 256 ? (u.pm >> 4) : NB) * MODW + gate_idx * D + col0;
        const f32x4 g0 = *(const f32x4*)gp, g1 = *(const f32x4*)(gp + 4);
#pragma unroll
        for (int ai = 0; ai < 2; ++ai)
#pragma unroll
            for (int m = 0; m < 4; ++m) { float* rowp = XZ + (size_t)(row0 + ai * HALF + m * 16) * D + col0;
#pragma unroll
                for (int n = 0; n < 2; ++n) { f32x4 y;
#pragma unroll
                    for (int j = 0; j < 4; ++j) y[j] = acc[ai][0][m][n][j] * fsigmoid(acc[ai][1][m][n][j]);
                    f32x4* p = (f32x4*)(rowp + 4 * n); const f32x4 x = *p; *p = x * DN_ALPHA + (n ? g1 : g0) * y; } }
    }
};

__device__ __forceinline__ void transpose_item(const float* W, int N, bf16* WT, int ldk, int mode, int NH, LAS float* scr, int item, int lane) {
    const int nblk = N / 32, kb = item / nblk, nb = item % nblk, k0 = 64 * kb, n0 = 32 * nb;
#pragma unroll 8
    for (int i = 0; i < 32; ++i) { const int kk = 2 * i + (lane >> 5); scr[kk * 33 + (lane & 31)] = W[(size_t)(k0 + kk) * N + n0 + (lane & 31)]; }
    asm volatile("s_waitcnt lgkmcnt(0)" ::: "memory");
    int r0 = n0;
    if (mode == 1) { const int half = n0 / NH, j = n0 - half * NH; r0 = 256 * (j >> 7) + 128 * half + (j & 127); }
    const int c = lane & 7;
#pragma unroll
    for (int j = 0; j < 4; ++j) { const int n = (lane >> 3) + 8 * j; const LAS float* s = scr + (8 * c) * 33 + n;
        u32x4 o; o.x = cvt_pk_bf16(s[0 * 33], s[1 * 33]); o.y = cvt_pk_bf16(s[2 * 33], s[3 * 33]); o.z = cvt_pk_bf16(s[4 * 33], s[5 * 33]); o.w = cvt_pk_bf16(s[6 * 33], s[7 * 33]);
        *(u32x4*)(WT + (size_t)(r0 + n) * ldk + k0 + 8 * c) = o; }
    asm volatile("s_waitcnt lgkmcnt(0)" ::: "memory");
}
__device__ __forceinline__ void convert_ffn_layer(const float* w13a, const float* w2a, const float* w13b, const float* w2b, unsigned char* ws, LAS float* scr, int gw, int NGW, int lane) {
    constexpr int I13 = (D / 64) * (2 * FF / 32), I2 = (FF / 64) * (D / 32);
    for (int it = gw; it < 2 * (I13 + I2); it += NGW) {
        int r = it;
        if (r < I13) { transpose_item(w13a, 2 * FF, (bf16*)(ws + WS_W13A), D, 1, FF, scr, r, lane); continue; } r -= I13;
        if (r < I2) { transpose_item(w2a, D, (bf16*)(ws + WS_W2A), FF, 0, 0, scr, r, lane); continue; } r -= I2;
        if (r < I13) { transpose_item(w13b, 2 * FF, (bf16*)(ws + WS_W13B), D, 1, FF, scr, r, lane); continue; } r -= I13;
        transpose_item(w2b, D, (bf16*)(ws + WS_W2B), FF, 0, 0, scr, r, lane);
    }
}

template <int MODE>
__device__ __forceinline__ void row_phase(int gw, int NGW, int lane, int nrows, const float* xin, const float* ctxin, float* XZ, bf16* H,
                                          const float* lng, const float* lnb, const float* modl, int shift_idx, int scale_idx, float* out) {
    for (int r = gw; r < nrows; r += NGW) {
        const float* src = MODE == 0 ? (r < RL ? xin + (size_t)r * D : ctxin + (size_t)(r - RL) * D) : XZ + (size_t)r * D;
        f32x4 v[8];
#pragma unroll
        for (int j = 0; j < 8; ++j) v[j] = *(const f32x4*)(src + 4 * lane + 256 * j);
        if (MODE == 1) {
            float s = 0.f;
#pragma unroll
            for (int j = 0; j < 8; ++j) s += (v[j].x + v[j].y) + (v[j].z + v[j].w);
            const float mean = wave_sum(s) * (1.f / D); float s2 = 0.f;
#pragma unroll
            for (int j = 0; j < 8; ++j) { v[j] = v[j] - mean; s2 += (v[j].x * v[j].x + v[j].y * v[j].y) + (v[j].z * v[j].z + v[j].w * v[j].w); }
            const float rstd = 1.f / sqrtf(wave_sum(s2) * (1.f / D) + LN_EPS);
#pragma unroll
            for (int j = 0; j < 8; ++j) { const f32x4 gg = *(const f32x4*)(lng + 4 * lane + 256 * j), bb = *(const f32x4*)(lnb + 4 * lane + 256 * j); v[j] = v[j] * rstd * gg + bb; }
        }
#pragma unroll
        for (int j = 0; j < 8; ++j) *(f32x4*)(XZ + (size_t)r * D + 4 * lane + 256 * j) = v[j];
        if (out && r < RL) {
#pragma unroll
            for (int j = 0; j < 8; ++j) *(f32x4*)(out + (size_t)r * D + 4 * lane + 256 * j) = v[j];
        }
        if (H) {
            const float* mp = modl + (size_t)row_batch(r) * MODW;
#pragma unroll
            for (int j = 0; j < 8; ++j) { const int c = 4 * lane + 256 * j; const f32x4 sh = *(const f32x4*)(mp + shift_idx * D + c), sc = *(const f32x4*)(mp + scale_idx * D + c);
                const f32x4 h = v[j] * (sc + 1.0f) + sh; u32x2 w; w.x = cvt_pk_bf16(h.x, h.y); w.y = cvt_pk_bf16(h.z, h.w);
                *(u32x2*)(H + (size_t)r * D + c) = w; }
        }
    }
}
__device__ __forceinline__ void pool_phase(int gw, int NGW, int lane, const float* XZ, bf16* H, const float* modl, int scale_idx) {
    for (int r = gw; r < R; r += NGW) {
        int pos, n; if (r < RL) { pos = r & 63; n = 64; } else { pos = (r - RL) & 255; n = 256; }
        const int base = r - pos; const float* mp = modl + (size_t)row_batch(r) * MODW + scale_idx * D;
#pragma unroll
        for (int j = 0; j < 8; ++j) { const int c = 4 * lane + 256 * j, W = 2 << (j >> 1);
            int lo = pos - W / 2; lo = lo < 0 ? 0 : lo; int hi = pos + W - W / 2 - 1; hi = hi > n - 1 ? n - 1 : hi;
            f32x4 a = (f32x4){0.f, 0.f, 0.f, 0.f};
            for (int p = lo; p <= hi; ++p) a += *(const f32x4*)(XZ + (size_t)(base + p) * D + c);
            const f32x4 self = *(const f32x4*)(XZ + (size_t)r * D + c), sc = *(const f32x4*)(mp + c);
            const f32x4 h = (a * (1.0f / (float)(hi - lo + 1)) - self) * (sc + 1.0f);
            u32x2 w; w.x = cvt_pk_bf16(h.x, h.y); w.y = cvt_pk_bf16(h.z, h.w); *(u32x2*)(H + (size_t)r * D + c) = w; }
    }
}
template <int HD>
__device__ __forceinline__ void readout_phase(int gw, int NGW, int lane, const float* O1, const float* O2, const bf16* PROJ, int ldp, int gcol, const float* norm_g, bf16* H) {
    for (int r = gw; r < R; r += NGW) {
#pragma unroll
        for (int j = 0; j < 8; ++j) { const int c = 4 * lane + 256 * j;
            const f32x4 o = *(const f32x4*)(O1 + (size_t)r * D + c) + *(const f32x4*)(O2 + (size_t)r * D + c);
            float s = (o.x * o.x + o.y * o.y) + (o.z * o.z + o.w * o.w);
#pragma unroll
            for (int off = 1; off < (HD == 128 ? 32 : 64); off <<= 1) s += __shfl_xor(s, off);
            const float rs = 1.0f / sqrtf(s * (1.0f / HD) + RMS_EPS);
            const u32x2 gw2 = *(const u32x2*)(PROJ + (size_t)r * ldp + gcol + c); const f32x4 ng = *(const f32x4*)(norm_g + c);
            f32x4 h; h.x = o.x * rs * ng.x * bf_lo(gw2.x); h.y = o.y * rs * ng.y * bf_hi(gw2.x); h.z = o.z * rs * ng.z * bf_lo(gw2.y); h.w = o.w * rs * ng.w * bf_hi(gw2.y);
            u32x2 w; w.x = cvt_pk_bf16(h.x, h.y); w.y = cvt_pk_bf16(h.z, h.w); *(u32x2*)(H + (size_t)r * D + c) = w; }
    }
}
__device__ __forceinline__ void s5_readout_phase(int gw, int NGW, int lane, const float* Y1, const float* Y2, const float* XZ, const float* dskip, const float* modl, int shift_idx, int scale_idx, bf16* H) {
    for (int r = gw; r < R; r += NGW) {
        const float* mp = modl + (size_t)row_batch(r) * MODW;
#pragma unroll
        for (int j = 0; j < 8; ++j) { const int c = 4 * lane + 256 * j;
            const f32x4 x = *(const f32x4*)(XZ + (size_t)r * D + c), sh = *(const f32x4*)(mp + shift_idx * D + c), sc = *(const f32x4*)(mp + scale_idx * D + c), dk = *(const f32x4*)(dskip + c);
            const f32x4 y = *(const f32x4*)(Y1 + (size_t)r * D + c) + *(const f32x4*)(Y2 + (size_t)r * D + c) + dk * (x * (sc + 1.0f) + sh);
            u32x2 w; w.x = cvt_pk_bf16(gelu_tanh(y.x), gelu_tanh(y.y)); w.y = cvt_pk_bf16(gelu_tanh(y.z), gelu_tanh(y.w)); *(u32x2*)(H + (size_t)r * D + c) = w; }
    }
}

__device__ __forceinline__ void hgrn_scan(LAS unsigned char* lds, const bf16* PROJ, float* Of, float* Ob, int tid) {
    constexpr int TB = 16, QS = 144, LDP = 5 * D;
    LAS float* qs = (LAS float*)lds;
    LAS float* ks = qs + 2 * TB * QS;
    LAS float* vs = ks + 2 * TB * QS;
    const int lane = tid & 63, w = tid >> 6, vloc = lane >> 2, kq = lane & 3, v = 16 * w + vloc;
    const int sA = (tid >> 4) & 15, arrA = tid >> 8, chunk = tid & 15;
    for (int seq = blockIdx.x; seq < NB * 16 * 2; seq += gridDim.x) {
        const int d = seq & 1, head = (seq >> 1) & 15, b = seq >> 5;
        float* O = d ? Ob : Of;
        const int colA = (arrA == 0 ? head * 128 : 3 * D + d * D + head * 128) + chunk * 8, colV = D + head * 128 + chunk * 8;
        f32x2 S[16];
#pragma unroll
        for (int j = 0; j < 16; ++j) S[j] = (f32x2){0.f, 0.f};
        u32x4 ra, rv = (u32x4){0u, 0u, 0u, 0u};
        ra = *(const u32x4*)(PROJ + (size_t)scan_row(b, d, sA) * LDP + colA);
        if (tid < 256) rv = *(const u32x4*)(PROJ + (size_t)scan_row(b, d, sA) * LDP + colV);
        __syncthreads();
#define HG_WRITE(buf) do { LAS float* dq = (arrA ? ks : qs) + ((buf) * TB + sA) * QS + chunk * 8 + 4 * (chunk >> 2); \
            *(LAS f32x4*)dq = (f32x4){bf_lo(ra.x), bf_hi(ra.x), bf_lo(ra.y), bf_hi(ra.y)}; *(LAS f32x4*)(dq + 4) = (f32x4){bf_lo(ra.z), bf_hi(ra.z), bf_lo(ra.w), bf_hi(ra.w)}; \
            if (tid < 256) { LAS float* dv = vs + ((buf) * TB + sA) * 128 + chunk * 8; \
                *(LAS f32x4*)dv = (f32x4){bf_lo(rv.x), bf_hi(rv.x), bf_lo(rv.y), bf_hi(rv.y)}; *(LAS f32x4*)(dv + 4) = (f32x4){bf_lo(rv.z), bf_hi(rv.z), bf_lo(rv.w), bf_hi(rv.w)}; } } while (0)
        HG_WRITE(0);
        __syncthreads();
        for (int nb = 0; nb < NSTEP / TB; ++nb) {
            const int buf = nb & 1;
            if (nb + 1 < NSTEP / TB) { const size_t ro = (size_t)scan_row(b, d, (nb + 1) * TB + sA) * LDP; ra = *(const u32x4*)(PROJ + ro + colA); if (tid < 256) rv = *(const u32x4*)(PROJ + ro + colV); }
            for (int s = 0; s < TB; ++s) {
                const LAS f32x4* q4 = (const LAS f32x4*)(qs + (buf * TB + s) * QS + kq * 36);
                const LAS f32x4* k4 = (const LAS f32x4*)(ks + (buf * TB + s) * QS + kq * 36);
                const float vv = vs[(buf * TB + s) * 128 + v];
                f32x2 o2 = (f32x2){0.f, 0.f};
#pragma unroll
                for (int jj = 0; jj < 8; ++jj) { const f32x4 q = q4[jj], k = k4[jj];
                    const f32x2 k01 = (f32x2){k.x, k.y}, k23 = (f32x2){k.z, k.w}, q01 = (f32x2){q.x, q.y}, q23 = (f32x2){q.z, q.w};
                    S[2 * jj] = (1.0f - k01) * S[2 * jj] + k01 * vv; o2 += q01 * S[2 * jj];
                    S[2 * jj + 1] = (1.0f - k23) * S[2 * jj + 1] + k23 * vv; o2 += q23 * S[2 * jj + 1]; }
                float o = o2.x + o2.y; o += __shfl_xor(o, 1); o += __shfl_xor(o, 2);
                if (kq == 0) O[(size_t)scan_row(b, d, nb * TB + s) * D + head * 128 + v] = o;
            }
            if (nb + 1 < NSTEP / TB) HG_WRITE(buf ^ 1);
            __syncthreads();
        }
#undef HG_WRITE
    }
}
__device__ __forceinline__ void mlstm_scan(LAS unsigned char* lds, const bf16* PROJ, const float* gates, float* Hf, float* Hb, int tid) {
    constexpr int TB = 16, QS = 272, LDP = 4 * D;
    LAS float* qs = (LAS float*)lds;
    LAS float* ks = qs + 2 * TB * QS;
    LAS float* vs = ks + 2 * TB * QS;
    LAS float* gs = vs + 2 * TB * 128;
    const int lane = tid & 63, w = tid >> 6, vloc = lane >> 2, kq = lane & 3;
    const int sQ = tid >> 5, chQ = tid & 31, sV = (tid >> 4) & 15, chV = tid & 15, sG = (tid >> 1) & 15, whG = tid & 1;
    for (int seq = blockIdx.x; seq < NB * 8 * 2 * 2; seq += gridDim.x) {
        const int vh = seq & 1, d = (seq >> 1) & 1, head = (seq >> 2) & 7, b = seq >> 5;
        float* Hd = d ? Hb : Hf;
        const int colQ = head * 256 + chQ * 8, colK = D + head * 256 + chQ * 8, colV = 2 * D + head * 256 + vh * 128 + chV * 8, colG = d * 16 + whG * 8 + head;
        f32x2 C[32];
#pragma unroll
        for (int j = 0; j < 32; ++j) C[j] = (f32x2){0.f, 0.f};
        f32x4 n4 = (f32x4){0.f, 0.f, 0.f, 0.f}; float mst = 0.f;
        u32x4 rq, rk, rv = (u32x4){0u, 0u, 0u, 0u}; float rg = 0.f;
        { const size_t ro = (size_t)scan_row(b, d, sQ) * LDP; rq = *(const u32x4*)(PROJ + ro + colQ); rk = *(const u32x4*)(PROJ + ro + colK); }
        if (tid < 256) rv = *(const u32x4*)(PROJ + (size_t)scan_row(b, d, sV) * LDP + colV);
        if (tid < 32) rg = gates[(size_t)scan_row(b, d, sG) * 32 + colG];
        __syncthreads();
#define ML_W8(dst, r) do { *(LAS f32x4*)(dst) = (f32x4){bf_lo(r.x), bf_hi(r.x), bf_lo(r.y), bf_hi(r.y)}; *(LAS f32x4*)((dst) + 4) = (f32x4){bf_lo(r.z), bf_hi(r.z), bf_lo(r.w), bf_hi(r.w)}; } while (0)
#define ML_WRITE(buf) do { ML_W8(qs + ((buf) * TB + sQ) * QS + chQ * 8 + 4 * (chQ >> 3), rq); ML_W8(ks + ((buf) * TB + sQ) * QS + chQ * 8 + 4 * (chQ >> 3), rk); \
            if (tid < 256) ML_W8(vs + ((buf) * TB + sV) * 128 + chV * 8, rv); if (tid < 32) gs[((buf) * TB + sG) * 2 + whG] = rg; } while (0)
        ML_WRITE(0);
        __syncthreads();
        for (int nb = 0; nb < NSTEP / TB; ++nb) {
            const int buf = nb & 1;
            if (nb + 1 < NSTEP / TB) { const int n1 = (nb + 1) * TB; const size_t ro = (size_t)scan_row(b, d, n1 + sQ) * LDP; rq = *(const u32x4*)(PROJ + ro + colQ); rk = *(const u32x4*)(PROJ + ro + colK);
                if (tid < 256) rv = *(const u32x4*)(PROJ + (size_t)scan_row(b, d, n1 + sV) * LDP + colV); if (tid < 32) rg = gates[(size_t)scan_row(b, d, n1 + sG) * 32 + colG]; }
            for (int s = 0; s < TB; ++s) {
                const float logi = gs[(buf * TB + s) * 2], logf = gs[(buf * TB + s) * 2 + 1];
                const float mnew = fmaxf(logf + mst, logi), fd = __expf(logf + mst - mnew), iw = __expf(logi - mnew); mst = mnew;
                const LAS f32x4* q4 = (const LAS f32x4*)(qs + (buf * TB + s) * QS + kq * 68);
                const LAS f32x4* k4 = (const LAS f32x4*)(ks + (buf * TB + s) * QS + kq * 68);
                const float ikv = iw * vs[(buf * TB + s) * 128 + 16 * w + vloc];
                f32x2 o2 = (f32x2){0.f, 0.f};
#pragma unroll
                for (int jj = 0; jj < 16; ++jj) { const f32x4 q = q4[jj], k = k4[jj];
                    const f32x2 k01 = (f32x2){k.x, k.y}, k23 = (f32x2){k.z, k.w}, q01 = (f32x2){q.x, q.y}, q23 = (f32x2){q.z, q.w};
                    C[2 * jj] = fd * C[2 * jj] + k01 * ikv; o2 += q01 * C[2 * jj];
                    C[2 * jj + 1] = fd * C[2 * jj + 1] + k23 * ikv; o2 += q23 * C[2 * jj + 1]; }
                float num = o2.x + o2.y; num += __shfl_xor(num, 1); num += __shfl_xor(num, 2);
                const int po = 4 * lane + 4 * (lane >> 4);
                const f32x4 kn = *(const LAS f32x4*)(ks + (buf * TB + s) * QS + po), qn = *(const LAS f32x4*)(qs + (buf * TB + s) * QS + po);
                n4 = fd * n4 + iw * kn;
                const float den = wave_sum((qn.x * n4.x + qn.y * n4.y) + (qn.z * n4.z + qn.w * n4.w));
                const float hval = num / fmaxf(fabsf(den), __expf(-mst));
                if (kq == 0) Hd[(size_t)scan_row(b, d, nb * TB + s) * D + head * 256 + vh * 128 + 16 * w + vloc] = hval;
            }
            if (nb + 1 < NSTEP / TB) ML_WRITE(buf ^ 1);
            __syncthreads();
        }
#undef ML_WRITE
#undef ML_W8
    }
}
__device__ __forceinline__ void s5_scan(LAS unsigned char* lds, const float* XZ, const float* modl, int shift_idx, int scale_idx,
                                        const float* abar, const float* bbar, const float* cre, const float* cim, float* Yf, float* Yb, int tid) {
    constexpr int TB = 32;
    const int lane = tid & 63, w = tid >> 6;
    LAS float* us = (LAS float*)lds + w * (2 * TB * 16);
    const int sL = lane >> 1, hL = lane & 1;
    for (int seq = blockIdx.x * 8 + w; seq < NB * 128 * 2; seq += gridDim.x * 8) {
        const int d = seq & 1, g = (seq >> 1) & 127, b = seq >> 8;
        float* Y = d ? Yb : Yf;
        const float ar = abar[(d * 128 + g) * 64 + lane], ai = abar[2 * 128 * 64 + (d * 128 + g) * 64 + lane];
        float bbr[16], bbi[16], cr[16], ci[16];
#pragma unroll
        for (int i = 0; i < 16; ++i) { bbr[i] = bbar[((size_t)(d * 128 + g) * 64 + lane) * 16 + i]; bbi[i] = bbar[(size_t)2 * 128 * 64 * 16 + ((size_t)(d * 128 + g) * 64 + lane) * 16 + i];
            cr[i] = cre[((size_t)(d * 128 + g) * 16 + i) * 64 + lane]; ci[i] = cim[((size_t)(d * 128 + g) * 16 + i) * 64 + lane]; }
        const int cL = g * 16 + hL * 8;
        f32x4 sc0, sc1, sh0, sh1, sc0c, sc1c, sh0c, sh1c;
        { const float* mp = modl + (size_t)b * MODW; sc0 = *(const f32x4*)(mp + scale_idx * D + cL) + 1.0f; sc1 = *(const f32x4*)(mp + scale_idx * D + cL + 4) + 1.0f; sh0 = *(const f32x4*)(mp + shift_idx * D + cL); sh1 = *(const f32x4*)(mp + shift_idx * D + cL + 4);
          const float* mc = modl + (size_t)NB * MODW; sc0c = *(const f32x4*)(mc + scale_idx * D + cL) + 1.0f; sc1c = *(const f32x4*)(mc + scale_idx * D + cL + 4) + 1.0f; sh0c = *(const f32x4*)(mc + shift_idx * D + cL); sh1c = *(const f32x4*)(mc + shift_idx * D + cL + 4); }
        float xr = 0.f, xi = 0.f;
        f32x4 r0, r1;
        { const float* p = XZ + (size_t)scan_row(b, d, sL) * D + cL; r0 = *(const f32x4*)p; r1 = *(const f32x4*)(p + 4); }
#define S5_WRITE(buf, isctx) do { LAS float* du = us + ((buf) * TB + sL) * 16 + hL * 8; \
            *(LAS f32x4*)du = (isctx) ? r0 * sc0c + sh0c : r0 * sc0 + sh0; *(LAS f32x4*)(du + 4) = (isctx) ? r1 * sc1c + sh1c : r1 * sc1 + sh1; } while (0)
        S5_WRITE(0, true);
        __builtin_amdgcn_wave_barrier(); asm volatile("s_waitcnt lgkmcnt(0)" ::: "memory");
        for (int nb = 0; nb < NSTEP / TB; ++nb) {
            const int buf = nb & 1;
            if (nb + 1 < NSTEP / TB) { const float* p = XZ + (size_t)scan_row(b, d, (nb + 1) * TB + sL) * D + cL; r0 = *(const f32x4*)p; r1 = *(const f32x4*)(p + 4); }
            for (int s = 0; s < TB; ++s) {
                const LAS f32x4* u4 = (const LAS f32x4*)(us + (buf * TB + s) * 16);
                float bur = 0.f, bui = 0.f;
#pragma unroll
                for (int q = 0; q < 4; ++q) { const f32x4 u = u4[q];
                    bur += bbr[4 * q] * u.x + bbr[4 * q + 1] * u.y + bbr[4 * q + 2] * u.z + bbr[4 * q + 3] * u.w;
                    bui += bbi[4 * q] * u.x + bbi[4 * q + 1] * u.y + bbi[4 * q + 2] * u.z + bbi[4 * q + 3] * u.w; }
                const float nxr = ar * xr - ai * xi + bur, nxi = ar * xi + ai * xr + bui; xr = nxr; xi = nxi;
                float yv[16];
#pragma unroll
                for (int i = 0; i < 16; ++i) yv[i] = cr[i] * xr - ci[i] * xi;
                float r8[8], r4[4], r2[2], r1v;
                { const bool hi = lane & 32;
#pragma unroll
                  for (int j = 0; j < 8; ++j) { const float send = hi ? yv[j] : yv[j + 8], keep = hi ? yv[j + 8] : yv[j]; r8[j] = keep + __shfl_xor(send, 32); } }
                { const bool hi = lane & 16;
#pragma unroll
                  for (int j = 0; j < 4; ++j) { const float send = hi ? r8[j] : r8[j + 4], keep = hi ? r8[j + 4] : r8[j]; r4[j] = keep + __shfl_xor(send, 16); } }
                { const bool hi = lane & 8;
#pragma unroll
                  for (int j = 0; j < 2; ++j) { const float send = hi ? r4[j] : r4[j + 2], keep = hi ? r4[j + 2] : r4[j]; r2[j] = keep + __shfl_xor(send, 8); } }
                { const bool hi = lane & 4; const float send = hi ? r2[0] : r2[1], keep = hi ? r2[1] : r2[0]; r1v = keep + __shfl_xor(send, 4); }
                r1v += __shfl_xor(r1v, 1); r1v += __shfl_xor(r1v, 2);
                const int oi = ((lane >> 5) & 1) * 8 + ((lane >> 4) & 1) * 4 + ((lane >> 3) & 1) * 2 + ((lane >> 2) & 1);
                if ((lane & 3) == 0) Y[(size_t)scan_row(b, d, nb * TB + s) * D + g * 16 + oi] = r1v;
            }
            if (nb + 1 < NSTEP / TB) { const bool isctx = (nb + 1) * TB < CT; S5_WRITE(buf ^ 1, isctx); }
            __builtin_amdgcn_wave_barrier(); asm volatile("s_waitcnt lgkmcnt(0)" ::: "memory");
        }
#undef S5_WRITE
    }
}


typedef float f32x16 __attribute__((ext_vector_type(16)));
typedef __bf16 bf16v2 __attribute__((ext_vector_type(2)));
__device__ __forceinline__ unsigned pkbf(float lo, float hi) { const f32x2 v = {lo, hi}; return __builtin_bit_cast(unsigned, __builtin_convertvector(v, bf16v2)); }
__device__ __forceinline__ bf16x8 pack8(const float* p, float sgn) {
    u32x4 w; w.x = pkbf(sgn * p[0], sgn * p[1]); w.y = pkbf(sgn * p[2], sgn * p[3]); w.z = pkbf(sgn * p[4], sgn * p[5]); w.w = pkbf(sgn * p[6], sgn * p[7]); return __builtin_bit_cast(bf16x8, w); }
__device__ __forceinline__ void s5_scan_mfma(LAS unsigned char* lds, const bf16* H, const float* abar, const float* bbar, const float* cre, const float* cim, float* Yf, float* Yb, int tid) {
    constexpr int XS = 272;
    const int lane = tid & 63, w = tid >> 6, r = lane & 31, h = lane >> 5, li = lane & 15, gq = lane >> 4;
    LAS unsigned char* xt = lds + w * (32 * XS);
    for (int seq = blockIdx.x * 8 + w; seq < NB * 128 * 2; seq += gridDim.x * 8) {
        const int d = seq & 1, g = (seq >> 1) & 127, b = seq >> 8, dg = d * 128 + g;
        float* Y = d ? Yb : Yf;
        const float ar = abar[dg * 64 + lane], ai = abar[2 * 128 * 64 + dg * 64 + lane];
        bf16x8 fb[4], fc[4];
#pragma unroll
        for (int tl = 0; tl < 4; ++tl) fb[tl] = pack8(bbar + (size_t)(tl >> 1) * (2 * 128 * 64 * 16) + ((size_t)dg * 64 + (tl & 1) * 32 + r) * 16 + 8 * h, 1.0f);
#pragma unroll
        for (int s = 0; s < 4; ++s) fc[s] = pack8((s < 2 ? cre : cim) + ((size_t)dg * 16 + li) * 64 + 32 * (s & 1) + 8 * gq, s < 2 ? 1.0f : -1.0f);
        float xr = 0.f, xi = 0.f;
        u32x4 ua = *(const u32x4*)(H + (size_t)scan_row(b, d, r) * D + g * 16 + 8 * h);
        for (int nb = 0; nb < NSTEP / 32; ++nb) {
            const bf16x8 fa = __builtin_bit_cast(bf16x8, ua);
            if (nb + 1 < NSTEP / 32) ua = *(const u32x4*)(H + (size_t)scan_row(b, d, (nb + 1) * 32 + r) * D + g * 16 + 8 * h);
            f32x16 z16;
#pragma unroll
            for (int j = 0; j < 16; ++j) z16[j] = 0.f;
            f32x16 c0 = __builtin_amdgcn_mfma_f32_32x32x16_bf16(fa, fb[0], z16, 0, 0, 0);
            f32x16 c1 = __builtin_amdgcn_mfma_f32_32x32x16_bf16(fa, fb[1], z16, 0, 0, 0);
            f32x16 c2 = __builtin_amdgcn_mfma_f32_32x32x16_bf16(fa, fb[2], z16, 0, 0, 0);
            f32x16 c3 = __builtin_amdgcn_mfma_f32_32x32x16_bf16(fa, fb[3], z16, 0, 0, 0);
#pragma unroll
            for (int j = 0; j < 16; ++j) {
                auto rr = __builtin_amdgcn_permlane32_swap(__float_as_uint(c0[j]), __float_as_uint(c1[j]), false, false); c0[j] = __uint_as_float(rr[0]); c1[j] = __uint_as_float(rr[1]);
                auto ri = __builtin_amdgcn_permlane32_swap(__float_as_uint(c2[j]), __float_as_uint(c3[j]), false, false); c2[j] = __uint_as_float(ri[0]); c3[j] = __uint_as_float(ri[1]);
            }
#define S5_STEP(bur, bui, t) do { const float nxr = ar * xr - ai * xi + (bur), nxi = ar * xi + ai * xr + (bui); xr = nxr; xi = nxi; \
                const unsigned pw = pkbf(xr, xi); *(LAS unsigned short*)(xt + (t) * XS + 2 * lane) = (unsigned short)pw; *(LAS unsigned short*)(xt + (t) * XS + 128 + 2 * lane) = (unsigned short)(pw >> 16); } while (0)
#pragma unroll
            for (int jj = 0; jj < 4; ++jj) {
#pragma unroll
                for (int q = 0; q < 4; ++q) S5_STEP(c0[4 * jj + q], c2[4 * jj + q], 8 * jj + q);
#pragma unroll
                for (int q = 0; q < 4; ++q) S5_STEP(c1[4 * jj + q], c3[4 * jj + q], 8 * jj + 4 + q);
            }
#undef S5_STEP
            asm volatile("s_waitcnt lgkmcnt(0)" ::: "memory"); __builtin_amdgcn_wave_barrier();
#pragma unroll
            for (int tb = 0; tb < 2; ++tb) {
                f32x4 acc = (f32x4){0.f, 0.f, 0.f, 0.f};
#pragma unroll
                for (int s = 0; s < 4; ++s) { const bf16x8 xb = *(const LAS bf16x8*)(xt + (16 * tb + li) * XS + (32 * s + 8 * gq) * 2); acc = __builtin_amdgcn_mfma_f32_16x16x32_bf16(fc[s], xb, acc, 0, 0, 0); }
                *(f32x4*)(Y + (size_t)scan_row(b, d, nb * 32 + 16 * tb + li) * D + g * 16 + 4 * gq) = acc;
            }
            asm volatile("s_waitcnt lgkmcnt(0)" ::: "memory"); __builtin_amdgcn_wave_barrier();
        }
    }
}

struct Args { const float* in[31]; float* out; unsigned char* ws; int ph_lo, ph_hi; };
enum { I_X = 0, I_C, I_CTX, I_CCTX, I_MODW, I_MODB, I_LNG, I_LNB, I_F1W13, I_F1W2, I_F2W13, I_F2W2, I_HGWIN, I_HGLB, I_HGNG, I_HGWO, I_POOLW, I_POOLS,
       I_MLWIN, I_MLGB, I_MLNG, I_MLWO, I_S5LRE, I_S5LIM, I_S5LDT, I_S5BRE, I_S5BIM, I_S5CRE, I_S5CIM, I_S5D, I_S5GLU };

__global__ void __launch_bounds__(512, 2) mega(Args a) {
    extern __shared__ __attribute__((aligned(16))) unsigned char lds_raw[];
    LAS unsigned char* lds = (LAS unsigned char*)lds_raw;
    volatile LAS unsigned* MISC = (volatile LAS unsigned*)(lds + MISC_OFF);
    const int tid = threadIdx.x, lane = tid & 63, wave = __builtin_amdgcn_readfirstlane(tid >> 6);
    const int gw = blockIdx.x * 8 + wave, NGW = gridDim.x * 8;
    unsigned char* ws = a.ws;
    for (int u = tid; u < (LDS_BYTES - RING_BYTES) / 4; u += 512) ((LAS unsigned*)(lds + RING_BYTES))[u] = 0u;
    __syncthreads();
    XcdBarrier bar = xcd_barrier_post((unsigned*)(ws + WS_CTL) + CW_BAR, MISC + 8);
    const int lo = a.ph_lo, hi = a.ph_hi; int ph = 0;
#define PH_BEGIN if (ph >= lo && ph < hi) {
#define PH_END if (ph + 1 < hi) xcd_barrier(bar); } ++ph;

    float* MODV = (float*)(ws + WS_MODV); float* LB = (float*)(ws + WS_LB); float* S5A = (float*)(ws + WS_S5A); float* S5B = (float*)(ws + WS_S5B); float* GATES = (float*)(ws + WS_GATES);
    float* XZ = (float*)(ws + WS_XZ); bf16* H = (bf16*)(ws + WS_H); unsigned char* BIG = ws + WS_BIG;

    PH_BEGIN
    {
        LAS float* s_lds = (LAS float*)lds;
        LAS float* red = s_lds + 9 * D;
        for (int i = tid; i < 9 * D; i += 512) { const float x = i < 8 * D ? a.in[I_C][i] : a.in[I_CCTX][i - 8 * D]; s_lds[i] = fsilu(x); }
        __syncthreads();
        for (int item = blockIdx.x; item < DEPTH * (MODW / 64); item += gridDim.x) {
            const int l = item / (MODW / 64), n0 = (item % (MODW / 64)) * 64;
            const float* wp = a.in[I_MODW] + ((size_t)l * D + wave * 256) * MODW + n0 + lane;
            float acc[9];
#pragma unroll
            for (int j = 0; j < 9; ++j) acc[j] = 0.f;
#pragma unroll 4
            for (int k = 0; k < 256; k += 4) {
                const float w0 = wp[(size_t)k * MODW], w1 = wp[(size_t)(k + 1) * MODW], w2 = wp[(size_t)(k + 2) * MODW], w3 = wp[(size_t)(k + 3) * MODW];
#pragma unroll
                for (int j = 0; j < 9; ++j) { const f32x4 s4 = *(const LAS f32x4*)(s_lds + j * D + wave * 256 + k); acc[j] += (w0 * s4.x + w1 * s4.y) + (w2 * s4.z + w3 * s4.w); }
            }
#pragma unroll
            for (int j = 0; j < 9; ++j) red[(wave * 9 + j) * 64 + lane] = acc[j];
            __syncthreads();
            for (int o = tid; o < 9 * 64; o += 512) { const int j = o >> 6, ln = o & 63; float s = 0.f;
#pragma unroll
                for (int ww = 0; ww < 8; ++ww) s += red[(ww * 9 + j) * 64 + ln];
                MODV[((size_t)l * 9 + j) * MODW + n0 + ln] = s + a.in[I_MODB][(size_t)l * MODW + n0 + ln]; }
            __syncthreads();
        }
        for (int i = blockIdx.x * 512 + tid; i < 2 * D; i += gridDim.x * 512) { const int dd = i / D, c = i % D; const float* lp = a.in[I_HGLB] + (size_t)dd * DEPTH * D + c;
            float mx = lp[0]; for (int j = 1; j < DEPTH; ++j) mx = fmaxf(mx, lp[(size_t)j * D]); float sum = 0.f; for (int j = 0; j < DEPTH; ++j) sum += expf(lp[(size_t)j * D] - mx);
            LB[i] = expf(lp[0] - mx) / sum; }
        for (int i = blockIdx.x * 512 + tid; i < 2 * 128 * 64; i += gridDim.x * 512) { const int dg = i >> 6;
            const double lre = a.in[I_S5LRE][i], lim = a.in[I_S5LIM][i], dt = exp((double)a.in[I_S5LDT][dg]);
            const double mag = exp(lre * dt), abr = mag * cos(lim * dt), abi = mag * sin(lim * dt), den = lre * lre + lim * lim;
            const double nr = abr - 1.0, ni = abi, fr = (nr * lre + ni * lim) / den, fi = (ni * lre - nr * lim) / den;
            S5A[i] = (float)abr; S5A[2 * 128 * 64 + i] = (float)abi;
            for (int q = 0; q < 16; ++q) { const double br = a.in[I_S5BRE][(size_t)i * 16 + q], bi = a.in[I_S5BIM][(size_t)i * 16 + q];
                S5B[(size_t)i * 16 + q] = (float)(fr * br - fi * bi); S5B[(size_t)2 * 128 * 64 * 16 + (size_t)i * 16 + q] = (float)(fr * bi + fi * br); } }
        LAS float* scr = (LAS float*)(lds + wave * 16384);
        constexpr int I_HI = (D / 64) * (5 * D / 32), I_DD = (D / 64) * (D / 32), I_PW = (512 / 64) * (512 / 32), I_MI = (D / 64) * (8224 / 32), I_GL = (D / 64) * (2 * D / 32);
        for (int it = gw; it < I_HI + 2 * I_DD + 4 * I_PW + I_MI + I_GL; it += NGW) {
            int r = it;
            if (r < I_HI) { transpose_item(a.in[I_HGWIN], 5 * D, (bf16*)(ws + WS_HGIN), D, 0, 0, scr, r, lane); continue; } r -= I_HI;
            if (r < I_DD) { transpose_item(a.in[I_HGWO], D, (bf16*)(ws + WS_HGO), D, 0, 0, scr, r, lane); continue; } r -= I_DD;
            if (r < I_DD) { transpose_item(a.in[I_MLWO], D, (bf16*)(ws + WS_MLO), D, 0, 0, scr, r, lane); continue; } r -= I_DD;
            if (r < 4 * I_PW) { const int gq = r / I_PW; transpose_item(a.in[I_POOLW] + (size_t)gq * 512 * 512, 512, (bf16*)(ws + WS_POOLW) + (size_t)gq * 512 * 512, 512, 0, 0, scr, r % I_PW, lane); continue; } r -= 4 * I_PW;
            if (r < I_MI) { transpose_item(a.in[I_MLWIN], 8224, (bf16*)(ws + WS_MLIN), D, 0, 0, scr, r, lane); continue; } r -= I_MI;
            transpose_item(a.in[I_S5GLU], 2 * D, (bf16*)(ws + WS_GLU), D, 1, D, scr, r, lane);
        }
        for (int i = blockIdx.x * 512 + tid; i < (MLN - 8224) * D / 8; i += gridDim.x * 512) ((u32x4*)((bf16*)(ws + WS_MLIN) + (size_t)8224 * D))[i] = (u32x4){0u, 0u, 0u, 0u};
        convert_ffn_layer(a.in[I_F1W13], a.in[I_F1W2], a.in[I_F2W13], a.in[I_F2W2], ws, scr, gw, NGW, lane);
    }
    PH_END

    PH_BEGIN
    row_phase<0>(gw, NGW, lane, R, a.in[I_X], a.in[I_CTX], XZ, H, nullptr, nullptr, MODV, 0, 1, nullptr);
    PH_END

#define LAYER_BODY(l) { \
        const float* modl = MODV + (size_t)l * 9 * MODW; \
        const float* lng = a.in[I_LNG] + (size_t)l * 3 * D; const float* lnb = a.in[I_LNB] + (size_t)l * 3 * D; \
        PH_BEGIN { pg8::Gemm g{H, (const bf16*)(ws + WS_W13A), R, 2 * FF, D, D, D, 0}; EpiSwiglu E{(bf16*)BIG}; pg8::gemm_phase(lds, g, E); if (PROBE_DUP & 2) pg8::gemm_phase(lds, g, E); } PH_END \
        PH_BEGIN { pg8::Gemm g{(const bf16*)BIG, (const bf16*)(ws + WS_W2A), R, D, FF, FF, FF, 0}; EpiResid E{XZ, modl, 2, 0.5f, nullptr}; pg8::gemm_phase(lds, g, E); } PH_END \
        PH_BEGIN row_phase<1>(gw, NGW, lane, R, nullptr, nullptr, XZ, H, lng, lnb, modl, 3, 4, nullptr); PH_END \
        const int MR = (l == DEPTH - 1) ? RL : R; \
        if (l == 0) { \
            PH_BEGIN { pg8::Gemm g{H, (const bf16*)(ws + WS_HGIN), R, 5 * D, D, D, D, 0}; EpiHgIn E{(bf16*)BIG, LB}; pg8::gemm_phase(lds, g, E); } PH_END \
            PH_BEGIN hgrn_scan(lds, (const bf16*)BIG, (float*)(BIG + BIG_O1_HG), (float*)(BIG + BIG_O2_HG), tid); if (PROBE_DUP & 1) { __syncthreads(); hgrn_scan(lds, (const bf16*)BIG, (float*)(BIG + BIG_O1_HG), (float*)(BIG + BIG_O2_HG), tid); } PH_END \
            PH_BEGIN readout_phase<128>(gw, NGW, lane, (const float*)(BIG + BIG_O1_HG), (const float*)(BIG + BIG_O2_HG), (const bf16*)BIG, 5 * D, 2 * D, a.in[I_HGNG], H); PH_END \
            PH_BEGIN { pg8::Gemm g{H, (const bf16*)(ws + WS_HGO), MR, D, D, D, D, 0}; EpiResid E{XZ, modl, 5, 1.0f, nullptr}; pg8::gemm_phase(lds, g, E); } PH_END \
        } \
        if (l == 1) { \
            PH_BEGIN pool_phase(gw, NGW, lane, XZ, H, modl, 4); PH_END \
            PH_BEGIN { pg8::Gemm g{H, (const bf16*)(ws + WS_POOLW), MR, D, 512, D, 512, 2}; EpiResid E{XZ, modl, 5, 1.0f, a.in[I_POOLS]}; pg8::gemm_phase(lds, g, E); } PH_END \
        } \
        if (l == 2) { \
            PH_BEGIN { pg8::Gemm g{H, (const bf16*)(ws + WS_MLIN), R, MLN, D, D, D, 0}; EpiMlIn E{(bf16*)BIG, GATES, a.in[I_MLGB]}; pg8::gemm_phase(lds, g, E); } PH_END \
            PH_BEGIN mlstm_scan(lds, (const bf16*)BIG, GATES, (float*)(BIG + BIG_O1_ML), (float*)(BIG + BIG_O2_ML), tid); if (PROBE_DUP & 1) { __syncthreads(); mlstm_scan(lds, (const bf16*)BIG, GATES, (float*)(BIG + BIG_O1_ML), (float*)(BIG + BIG_O2_ML), tid); } PH_END \
            PH_BEGIN readout_phase<256>(gw, NGW, lane, (const float*)(BIG + BIG_O1_ML), (const float*)(BIG + BIG_O2_ML), (const bf16*)BIG, 4 * D, 3 * D, a.in[I_MLNG], H); PH_END \
            PH_BEGIN { pg8::Gemm g{H, (const bf16*)(ws + WS_MLO), MR, D, D, D, D, 0}; EpiResid E{XZ, modl, 5, 1.0f, nullptr}; pg8::gemm_phase(lds, g, E); } PH_END \
        } \
        if (l == 3) { \
            PH_BEGIN s5_scan_mfma(lds, H, S5A, S5B, a.in[I_S5CRE], a.in[I_S5CIM], (float*)(BIG + BIG_O1_S5), (float*)(BIG + BIG_O2_S5), tid); if (PROBE_DUP & 1) { __syncthreads(); s5_scan_mfma(lds, H, S5A, S5B, a.in[I_S5CRE], a.in[I_S5CIM], (float*)(BIG + BIG_O1_S5), (float*)(BIG + BIG_O2_S5), tid); } PH_END \
            PH_BEGIN s5_readout_phase(gw, NGW, lane, (const float*)(BIG + BIG_O1_S5), (const float*)(BIG + BIG_O2_S5), XZ, a.in[I_S5D], modl, 3, 4, H); PH_END \
            PH_BEGIN { pg8::Gemm g{H, (const bf16*)(ws + WS_GLU), MR, 2 * D, D, D, D, 0}; EpiS5Glu E{XZ, modl, 5}; pg8::gemm_phase(lds, g, E); } PH_END \
        } \
        PH_BEGIN row_phase<1>(gw, NGW, lane, MR, nullptr, nullptr, XZ, H, lng + D, lnb + D, modl, 6, 7, nullptr); PH_END \
        PH_BEGIN { pg8::Gemm g{H, (const bf16*)(ws + WS_W13B), MR, 2 * FF, D, D, D, 0}; EpiSwiglu E{(bf16*)BIG}; pg8::gemm_phase(lds, g, E); if (PROBE_DUP & 2) pg8::gemm_phase(lds, g, E); } PH_END \
        PH_BEGIN { pg8::Gemm g{(const bf16*)BIG, (const bf16*)(ws + WS_W2B), MR, D, FF, FF, FF, 0}; EpiResid E{XZ, modl, 8, 0.5f, nullptr}; pg8::gemm_phase(lds, g, E); } PH_END \
        PH_BEGIN \
        if (l + 1 < DEPTH) { \
            row_phase<1>(gw, NGW, lane, R, nullptr, nullptr, XZ, H, lng + 2 * D, lnb + 2 * D, modl + (size_t)9 * MODW, 0, 1, nullptr); \
            const size_t o13 = (size_t)(l + 1) * D * 2 * FF, o2 = (size_t)(l + 1) * FF * D; \
            convert_ffn_layer(a.in[I_F1W13] + o13, a.in[I_F1W2] + o2, a.in[I_F2W13] + o13, a.in[I_F2W2] + o2, ws, (LAS float*)(lds + wave * 16384), gw, NGW, lane); \
        } else { \
            row_phase<1>(gw, NGW, lane, RL, nullptr, nullptr, XZ, nullptr, lng + 2 * D, lnb + 2 * D, modl, 0, 1, a.out); \
        } \
        PH_END \
    }
    LAYER_BODY(0) LAYER_BODY(1) LAYER_BODY(2) LAYER_BODY(3)
#undef LAYER_BODY
#undef PH_BEGIN
#undef PH_END
}

static int n_phases() { int n = 2; for (int l = 0; l < DEPTH; ++l) { n += 3; n += (l == 0 || l == 2) ? 4 : (l == 1 ? 2 : 3); n += 1 + 3; } return n; }

extern "C" void kernel_launch(void* const* d_in, const int* in_sizes, int n_in, void* d_out, int out_size, void* d_ws, size_t ws_size, hipStream_t stream) {
    static int grid = 0;
    if (grid == 0) {
        if (n_in != 31 || in_sizes[0] != RL * D || out_size != RL * D || ws_size < WS_END) {
            fprintf(stderr, "kernel_launch: unexpected problem: n_in %d in0 %d out %d ws %zu (need %zu)\n", n_in, n_in > 0 ? in_sizes[0] : -1, out_size, ws_size, (size_t)WS_END); grid = -1; return; }
        int dev = 0, cus = 0, per_cu = 0;
        if (hipGetDevice(&dev) != hipSuccess || hipDeviceGetAttribute(&cus, hipDeviceAttributeMultiprocessorCount, dev) != hipSuccess) { grid = -1; return; }
        if (hipFuncSetAttribute((const void*)mega, hipFuncAttributeMaxDynamicSharedMemorySize, LDS_BYTES) != hipSuccess) { fprintf(stderr, "kernel_launch: hipFuncSetAttribute failed\n"); grid = -1; return; }
        if (hipOccupancyMaxActiveBlocksPerMultiprocessor(&per_cu, (const void*)mega, 512, LDS_BYTES) != hipSuccess || per_cu < 1) fprintf(stderr, "kernel_launch: occupancy query reports %d\n", per_cu);
        (void)hipGetLastError();
        grid = cus;
    }
    if (grid < 0) return;
    (void)hipMemsetAsync((char*)d_ws + WS_CTL, 0, CTL_BYTES, stream);
    Args a{};
    for (int i = 0; i < 31; ++i) a.in[i] = (const float*)d_in[i];
    a.out = (float*)d_out; a.ws = (unsigned char*)d_ws;
    const int NPH = n_phases();
#if MK_MULTI
    for (int p = 0; p < NPH; ++p) { a.ph_lo = p; a.ph_hi = p + 1; hipLaunchKernelGGL(mega, dim3(grid), dim3(512), LDS_BYTES, stream, a); }
#else
    a.ph_lo = 0; a.ph_hi = NPH; hipLaunchKernelGGL(mega, dim3(grid), dim3(512), LDS_BYTES, stream, a);
#endif
}
```

```cpp
#include <hip/hip_runtime.h>
#include <cstdio>
#include <cstdint>

#ifndef MK_MULTI
#define MK_MULTI 0
#endif

#ifndef PROBE_DUP
#define PROBE_DUP 0
#endif
#define LAS __attribute__((address_space(3)))
typedef unsigned short bf16;
typedef short bf16x8 __attribute__((ext_vector_type(8)));
typedef float f32x4 __attribute__((ext_vector_type(4)));
typedef float f32x2 __attribute__((ext_vector_type(2)));
typedef unsigned u32x4 __attribute__((ext_vector_type(4)));
typedef unsigned u32x2 __attribute__((ext_vector_type(2)));

constexpr int D = 2048, NB = 8, T = 4096, CT = 256, DEPTH = 4, FF = 5632, NMOD = 9;
constexpr int RL = NB * T;
constexpr int RC = NB * CT;
constexpr int R = RL + RC;
constexpr int MODW = NMOD * D;
constexpr float DN_ALPHA = 1.6817928305074290f;
constexpr float LN_EPS = 1e-5f, RMS_EPS = 1e-6f;
constexpr int MLN = 8448;

constexpr size_t MiB = 1u << 20;
constexpr size_t WS_CTL = 0, CTL_BYTES = 1 * MiB;
constexpr size_t WS_MODV = 1 * MiB;
constexpr size_t WS_LB = 4 * MiB;
constexpr size_t WS_S5A = 5 * MiB;
constexpr size_t WS_S5B = 6 * MiB;
constexpr size_t WS_GATES = 8 * MiB;
constexpr size_t WS_HGIN = 17 * MiB;
constexpr size_t WS_HGO = 57 * MiB;
constexpr size_t WS_POOLW = 65 * MiB;
constexpr size_t WS_MLIN = 67 * MiB;
constexpr size_t WS_MLO = 100 * MiB;
constexpr size_t WS_GLU = 108 * MiB;
constexpr size_t WS_W13A = 124 * MiB, WS_W2A = 168 * MiB, WS_W13B = 190 * MiB, WS_W2B = 234 * MiB;
constexpr size_t WS_XZ = 256 * MiB;
constexpr size_t WS_H = 528 * MiB;
constexpr size_t WS_BIG = 664 * MiB;
constexpr size_t WS_END = (664 + 1224) * MiB;
constexpr size_t BIG_O1_HG = 680 * MiB, BIG_O2_HG = 952 * MiB;
constexpr size_t BIG_O1_ML = 544 * MiB, BIG_O2_ML = 816 * MiB;
constexpr size_t BIG_O1_S5 = 0, BIG_O2_S5 = 272 * MiB;
constexpr int CW_BAR = 4096;

constexpr int RING_BYTES = 131072, MISC_OFF = RING_BYTES + 320, LDS_BYTES = 147456;

__device__ __forceinline__ float bf_lo(unsigned w) { return __uint_as_float(w << 16); }
__device__ __forceinline__ float bf_hi(unsigned w) { return __uint_as_float(w & 0xffff0000u); }
__device__ __forceinline__ unsigned cvt_pk_bf16(float lo, float hi) { unsigned r; asm volatile("v_cvt_pk_bf16_f32 %0, %1, %2" : "=v"(r) : "v"(lo), "v"(hi)); return r; }
__device__ __forceinline__ float fsigmoid(float x) { return __builtin_amdgcn_rcpf(1.0f + __expf(-x)); }
__device__ __forceinline__ float fsilu(float x) { return x * fsigmoid(x); }
__device__ __forceinline__ float gelu_tanh(float x) { const float u = 1.5957691216057308f * (x + 0.044715f * x * x * x); return x * fsigmoid(u); }
__device__ __forceinline__ float wave_sum(float v) {
#pragma unroll
    for (int o = 1; o < 64; o <<= 1) v += __shfl_xor(v, o);
    return v;
}
__device__ __forceinline__ int row_batch(int r) { return r < RL ? (r >> 12) : NB; }
__device__ __forceinline__ int scan_row(int b, int d, int n) {
    if (n < CT) return RL + b * CT + (d ? CT - 1 - n : n);
    const int m = n - CT; return b * T + (d ? T - 1 - m : m);
}
constexpr int NSTEP = CT + T;

#define XB_TMO      128
#define XB_XCNT(j)  (256  + 64 * (j))
#define XB_XSUB(j)  (1280 + 64 * (j))
#define XB_XGEN(j)  (2304 + 64 * (j))
#define XB_TOP      3328
#define XB_TOPGEN   3392
#define XCD_BAR_WORDS 3456
#define XB_SPIN_CAP (1u << 18)
__device__ __forceinline__ unsigned xb_ld(unsigned* p)              { return __hip_atomic_load(p, __ATOMIC_RELAXED, __HIP_MEMORY_SCOPE_AGENT); }
__device__ __forceinline__ unsigned xb_add(unsigned* p, unsigned v) { return __hip_atomic_fetch_add(p, v, __ATOMIC_RELAXED, __HIP_MEMORY_SCOPE_AGENT); }
__device__ __forceinline__ unsigned xb_xcc_id() { return (unsigned)__builtin_amdgcn_s_getreg((3 << 11) | 20) & 0xFu; }
#define XB_SPIN(cond, bar) do { unsigned _sp = 0; while (cond) { __builtin_amdgcn_s_sleep(1); \
    if ((++_sp & 255u) == 0u) { if (xb_ld(&(bar)[XB_TMO])) break; if (_sp > XB_SPIN_CAP) { atomicAdd(&(bar)[XB_TMO], 1u); break; } } } } while (0)
struct XcdBarrier { unsigned* bar; unsigned x; volatile LAS unsigned* st; };
__device__ __forceinline__ XcdBarrier xcd_barrier_post(unsigned* bar, volatile LAS unsigned* st) {
    XcdBarrier b; b.bar = bar; b.x = xb_xcc_id(); b.st = st;
    if (threadIdx.x == 0) (void)xb_add(&bar[XB_XCNT(b.x)], 1u);
    return b;
}
__device__ __forceinline__ void xcd_barrier_complete(unsigned* bar, unsigned x, unsigned& nloc, unsigned& nx) {
    const unsigned G = gridDim.x * gridDim.y * gridDim.z;
    unsigned sum, cnt, mine, sp = 0u;
    for (;;) {
        sum = 0u; cnt = 0u; mine = 0u;
#pragma unroll
        for (unsigned j = 0; j < 16; ++j) { const unsigned c = xb_ld(&bar[XB_XCNT(j)]); sum += c; cnt += (c > 0u) ? 1u : 0u; mine = (j == x) ? c : mine; }
        if (sum == G) break;
        __builtin_amdgcn_s_sleep(1);
        if ((++sp & 255u) == 0u) { if (xb_ld(&bar[XB_TMO])) break; if (sp > XB_SPIN_CAP) { atomicAdd(&bar[XB_TMO], 1u); break; } }
    }
    nloc = mine > 0u ? mine : 1u; nx = cnt > 0u ? cnt : 1u;
}
__device__ __forceinline__ void xcd_barrier(const XcdBarrier& b) {
    asm volatile("s_waitcnt vmcnt(0)" ::: "memory");
    __syncthreads();
    if (threadIdx.x == 0) {
        unsigned* bar = b.bar;
        __builtin_amdgcn_s_waitcnt(0);
        unsigned nloc = b.st[0], nx = b.st[1];
        if (nloc == 0u) { xcd_barrier_complete(bar, b.x, nloc, nx); b.st[0] = nloc; b.st[1] = nx; }
        const unsigned old = xb_add(&bar[XB_XSUB(b.x)], 1u);
        const unsigned gen = old / nloc;
        if (old + 1u == (gen + 1u) * nloc) {
            __builtin_amdgcn_fence(__ATOMIC_RELEASE, "agent");
            asm volatile("s_waitcnt vmcnt(0)" ::: "memory");
            const unsigned og = xb_add(&bar[XB_TOP], 1u);
            const unsigned tg = og / nx;
            if (og + 1u == (tg + 1u) * nx) xb_add(&bar[XB_TOPGEN], 1u);
            else XB_SPIN(xb_ld(&bar[XB_TOPGEN]) == tg, bar);
            __builtin_amdgcn_fence(__ATOMIC_ACQUIRE, "agent");
            xb_add(&bar[XB_XGEN(b.x)], 1u);
            asm volatile("s_waitcnt vmcnt(0)" ::: "memory");
        } else {
            XB_SPIN(xb_ld(&bar[XB_XGEN(b.x)]) == gen, bar);
            __builtin_amdgcn_fence(__ATOMIC_ACQUIRE, "agent");
            asm volatile("s_waitcnt vmcnt(0)" ::: "memory");
        }
    }
    __syncthreads();
}

namespace pg8 {
constexpr int BM = 256, BK = 64, HALF = 128, HTB = HALF * BK * 2, STAGE_BYTES = 8 * HTB, NXCD = 8, WGM = 8;
__host__ __device__ __forceinline__ int lds_byte(int r, int c) { const int st = (r >> 4) * 2 + (c >> 5), rr = r & 15, cc = c & 31, ob = rr * 64 + cc * 2; return st * 1024 + (ob ^ (((ob >> 9) & 1) << 5)); }
__host__ __device__ __forceinline__ void stage_rc(int b, int& Rr, int& C) { const int st = b / 1024, sb = b % 1024, swz = sb ^ (((sb >> 9) & 1) << 5); Rr = (st >> 1) * 16 + swz / 64; C = (st & 1) * 32 + (swz % 64) / 2; }
__host__ __device__ __forceinline__ int perm32(int rho) { const int n = rho >> 4, i = rho & 15; return 8 * (i >> 2) + 4 * n + (i & 3); }
struct Unit { int pm, pn; };
struct Gemm { const bf16* A; const bf16* Bt; int M, N, K, lda, ldb, agrp; };
struct StaticOrder {
    int nM, nN, nwg, G, c;
    __device__ void init(int M, int N, int G_, int c_) { nM = M / BM; nN = N / BM; nwg = nM * nN; G = G_; c = c_; }
    __device__ bool next(int i, Unit& u) const {
        const long L = (long)i * G + c; if (L >= nwg) return false;
        int wgid = (int)L; { const int q = nwg / NXCD, r = nwg % NXCD, xcd = wgid % NXCD, off = wgid / NXCD; wgid = (xcd < r ? xcd * (q + 1) : r * (q + 1) + (xcd - r) * q) + off; }
        const int nig = WGM * nN, gid = wgid / nig, fm = gid * WGM, gsz = (nM - fm) < WGM ? (nM - fm) : WGM;
        u.pm = fm + ((wgid % nig) % gsz); u.pn = (wgid % nig) / gsz; return true;
    }
};
template <class Epi>
__device__ __forceinline__ void gemm_phase(LAS unsigned char* lds, const Gemm g, const Epi& E) {
    const int tid = threadIdx.x, wid = __builtin_amdgcn_readfirstlane(tid >> 6), lane = tid & 63, wr = wid >> 2, wc = wid & 3, fr = lane & 15, fq = lane >> 4;
    const int K = g.K, nt = K / BK;
    StaticOrder S; S.init(g.M, g.N, (int)gridDim.x, (int)blockIdx.x);
    unsigned voffA[2], voffB[2];
#pragma unroll
    for (int i = 0; i < 2; ++i) { int Rr, C; stage_rc(tid * 16 + i * 8192, Rr, C); const int Rb = Epi::PERM ? ((Rr & ~31) + perm32(Rr & 31)) : Rr;
        voffA[i] = (unsigned)(Rr * g.lda + C) * 2u; voffB[i] = (unsigned)(Rb * g.ldb + C) * 2u; }
    const size_t kstep = (size_t)(BK * 2);
    const size_t hstepA = (size_t)HALF * g.lda * 2, hstepB = (size_t)HALF * g.ldb * 2;
    const size_t tstepA = 2 * hstepA, tstepB = 2 * hstepB;
    const unsigned ldsw = (unsigned)wid * 1024u;
    const int aoff = lds_byte(wr * 64 + fr, fq * 8), boff = lds_byte(wc * 32 + fr, fq * 8);
#define PG8_ABASE(u) ((const char*)g.A + (size_t)(u).pm * tstepA + (g.agrp ? (size_t)((u).pn / g.agrp) * (size_t)K * 2 : (size_t)0))
#define PG8_BBASE(u) ((const char*)g.Bt + (size_t)(u).pn * tstepB)
#define PG8_SA(b, h) (((b) * 2 + (h)) * HTB)
#define PG8_SB(b, h) ((4 + (b) * 2 + (h)) * HTB)
#define PG8_STAGE(bufoff, gbase, voff) do { _Pragma("unroll") for (int _i = 0; _i < 2; ++_i) \
        __builtin_amdgcn_global_load_lds((const unsigned*)((const char*)(gbase) + (voff)[_i]), (LAS unsigned*)(lds + (bufoff) + ldsw + _i * 8192), 16, 0, 0); } while (0)
#define PG8_LDA(dst, b, h) do { _Pragma("unroll") for (int m = 0; m < 4; ++m) _Pragma("unroll") for (int k = 0; k < 2; ++k) dst[m][k] = *(const LAS bf16x8*)(lds + PG8_SA(b, h) + aoff + m * 2048 + k * 1024); } while (0)
#define PG8_LDB(dst, b, h) do { _Pragma("unroll") for (int n = 0; n < 2; ++n) _Pragma("unroll") for (int k = 0; k < 2; ++k) dst[n][k] = *(const LAS bf16x8*)(lds + PG8_SB(b, h) + boff + n * 2048 + k * 1024); } while (0)
#define PG8_MMA(ai, bj, At, Bt) do { __builtin_amdgcn_s_setprio(1); _Pragma("unroll") for (int m = 0; m < 4; ++m) _Pragma("unroll") for (int n = 0; n < 2; ++n) _Pragma("unroll") for (int k = 0; k < 2; ++k) \
        acc[ai][bj][m][n] = __builtin_amdgcn_mfma_f32_16x16x32_bf16(Bt[n][k], At[m][k], acc[ai][bj][m][n], 0, 0, 0); __builtin_amdgcn_s_setprio(0); } while (0)
#define PG8_WAIT_V(n) asm volatile("s_waitcnt vmcnt(" #n ")" ::: "memory")
#define PG8_WAIT_L(n) asm volatile("s_waitcnt lgkmcnt(" #n ")" ::: "memory")
#define PG8_BAR __builtin_amdgcn_s_barrier()
#define PG8_SCHED __builtin_amdgcn_sched_barrier(0)
    Unit cur, nxt; int ui = 0;
    if (!S.next(0, cur)) return;
    f32x4 acc[2][2][4][2];
#pragma unroll
    for (int a = 0; a < 2; ++a)
#pragma unroll
        for (int b = 0; b < 2; ++b)
#pragma unroll
            for (int m = 0; m < 4; ++m)
#pragma unroll
                for (int n = 0; n < 2; ++n) acc[a][b][m][n] = (f32x4){0.f, 0.f, 0.f, 0.f};
    bf16x8 At[4][2], B0[2][2], B1[2][2];
    const char* cA = PG8_ABASE(cur); const char* cB = PG8_BBASE(cur);
    PG8_STAGE(PG8_SB(0, 0), cB, voffB); PG8_STAGE(PG8_SB(0, 1), cB + hstepB, voffB); PG8_STAGE(PG8_SA(0, 0), cA, voffA); PG8_STAGE(PG8_SA(0, 1), cA + hstepA, voffA);
    if (wr == 1) PG8_BAR;
    PG8_WAIT_V(2); PG8_BAR;
    PG8_STAGE(PG8_SB(1, 0), cB + kstep, voffB); PG8_STAGE(PG8_SA(1, 0), cA + kstep, voffA); PG8_STAGE(PG8_SB(1, 1), cB + hstepB + kstep, voffB);
    PG8_WAIT_V(6); PG8_BAR;
    for (;;) {
        const bool has_next = S.next(ui + 1, nxt);
        const char* nA = has_next ? PG8_ABASE(nxt) : cA; const char* nB = has_next ? PG8_BBASE(nxt) : cB;
        for (int t = 0; t < nt; t += 2) {
            const bool last = (t == nt - 2);
            const char* a1 = cA + (size_t)(t + 1) * kstep;
            const char* a2 = last ? nA : cA + (size_t)(t + 2) * kstep; const char* b2 = last ? nB : cB + (size_t)(t + 2) * kstep;
            const char* a3 = a2 + kstep; const char* b3 = b2 + kstep;
            PG8_LDB(B0, 0, 0); PG8_LDB(B1, 0, 1); PG8_SCHED; PG8_LDA(At, 0, 0); PG8_STAGE(PG8_SA(1, 1), a1 + hstepA, voffA);
            PG8_WAIT_V(8); PG8_WAIT_L(0); PG8_BAR; PG8_MMA(0, 0, At, B0); PG8_MMA(0, 1, At, B1); PG8_BAR; PG8_SCHED;
            PG8_LDA(At, 0, 1); PG8_STAGE(PG8_SB(0, 0), b2, voffB); PG8_STAGE(PG8_SB(0, 1), b2 + hstepB, voffB); PG8_STAGE(PG8_SA(0, 0), a2, voffA);
            PG8_WAIT_V(8); PG8_WAIT_L(0); PG8_BAR; PG8_MMA(1, 0, At, B0); PG8_MMA(1, 1, At, B1); PG8_BAR; PG8_SCHED;
            PG8_LDB(B0, 1, 0); PG8_LDB(B1, 1, 1); PG8_SCHED; PG8_LDA(At, 1, 0); PG8_STAGE(PG8_SA(0, 1), a2 + hstepA, voffA);
            PG8_WAIT_V(8); PG8_WAIT_L(0); PG8_BAR; PG8_MMA(0, 0, At, B0); PG8_MMA(0, 1, At, B1); PG8_BAR; PG8_SCHED;
            PG8_LDA(At, 1, 1); PG8_STAGE(PG8_SB(1, 0), b3, voffB); PG8_STAGE(PG8_SB(1, 1), b3 + hstepB, voffB); PG8_STAGE(PG8_SA(1, 0), a3, voffA);
            PG8_WAIT_V(8); PG8_WAIT_L(0); PG8_BAR; PG8_MMA(1, 0, At, B0); PG8_MMA(1, 1, At, B1); PG8_BAR; PG8_SCHED;
        }
        if (wr == 0) PG8_BAR;
        E(acc, cur, wr, wc, fr, fq);
        if (!has_next) break;
#pragma unroll
        for (int a = 0; a < 2; ++a)
#pragma unroll
            for (int b = 0; b < 2; ++b)
#pragma unroll
                for (int m = 0; m < 4; ++m)
#pragma unroll
                    for (int n = 0; n < 2; ++n) acc[a][b][m][n] = (f32x4){0.f, 0.f, 0.f, 0.f};
        cur = nxt; cA = nA; cB = nB; ++ui;
        if (wr == 1) PG8_BAR;
    }
    PG8_WAIT_V(0);
    PG8_BAR;
#undef PG8_ABASE
#undef PG8_BBASE
#undef PG8_SA
#undef PG8_SB
#undef PG8_STAGE
#undef PG8_LDA
#undef PG8_LDB
#undef PG8_MMA
#undef PG8_WAIT_V
#undef PG8_WAIT_L
#undef PG8_BAR
#undef PG8_SCHED
}
}
using pg8::Unit; using pg8::HALF; using pg8::BM;
typedef f32x4 Acc[2][2][4][2];

struct EpiSwiglu {
    static constexpr bool PERM = true;
    bf16* O;
    __device__ __forceinline__ void operator()(const Acc& acc, const Unit& u, int wr, int wc, int fr, int fq) const {
        const int row0 = u.pm * BM + wr * 64 + fr, col0 = u.pn * HALF + wc * 32 + 8 * fq;
#pragma unroll
        for (int ai = 0; ai < 2; ++ai)
#pragma unroll
            for (int m = 0; m < 4; ++m) {
                float h[8];
#pragma unroll
                for (int n = 0; n < 2; ++n)
#pragma unroll
                    for (int j = 0; j < 4; ++j) { const float a = acc[ai][0][m][n][j], b = acc[ai][1][m][n][j]; h[4 * n + j] = fsilu(a) * b; }
                u32x4 w; w.x = cvt_pk_bf16(h[0], h[1]); w.y = cvt_pk_bf16(h[2], h[3]); w.z = cvt_pk_bf16(h[4], h[5]); w.w = cvt_pk_bf16(h[6], h[7]);
                *(u32x4*)(O + (size_t)(row0 + ai * HALF + m * 16) * FF + col0) = w;
            }
    }
};
struct EpiResid {
    static constexpr bool PERM = false;
    float* XZ; const float* modl; int gate_idx; float fac; const float* colscale;
    __device__ __forceinline__ void operator()(const Acc& acc, const Unit& u, int wr, int wc, int fr, int fq) const {
        const int row0 = u.pm * BM + wr * 64 + fr, col0 = u.pn * BM + wc * 32 + 4 * fq;
        const float* gp = modl + (size_t)(u.pm < RL / 256 ? (u.pm >> 4) : NB) * MODW + gate_idx * D;
        f32x4 gv[2][2];
#pragma unroll
        for (int bj = 0; bj < 2; ++bj)
#pragma unroll
            for (int n = 0; n < 2; ++n) { const int c = col0 + bj * HALF + n * 16; gv[bj][n] = *(const f32x4*)(gp + c) * fac; if (colscale) gv[bj][n] *= *(const f32x4*)(colscale + c); }
#pragma unroll
        for (int ai = 0; ai < 2; ++ai)
#pragma unroll
            for (int m = 0; m < 4; ++m) { float* rowp = XZ + (size_t)(row0 + ai * HALF + m * 16) * D + col0;
#pragma unroll
                for (int bj = 0; bj < 2; ++bj)
#pragma unroll
                    for (int n = 0; n < 2; ++n) { f32x4* p = (f32x4*)(rowp + bj * HALF + n * 16); const f32x4 x = *p; *p = x * DN_ALPHA + gv[bj][n] * acc[ai][bj][m][n]; }
                asm volatile("" ::: "memory"); }
    }
};
struct EpiHgIn {
    static constexpr bool PERM = true;
    bf16* O; const float* lb;
    __device__ __forceinline__ void operator()(const Acc& acc, const Unit& u, int wr, int wc, int fr, int fq) const {
        const int row0 = u.pm * BM + wr * 64 + fr, col0 = u.pn * BM + wc * 32 + 8 * fq, type = u.pn >> 3;
        float om[2][8];
        if (type >= 3) {
#pragma unroll
            for (int bj = 0; bj < 2; ++bj)
#pragma unroll
                for (int j = 0; j < 8; ++j) om[bj][j] = 1.0f - lb[(type - 3) * D + (col0 + bj * HALF + j - (3 + (type - 3)) * D)];
        }
#pragma unroll
        for (int ai = 0; ai < 2; ++ai)
#pragma unroll
            for (int m = 0; m < 4; ++m) { bf16* rowp = O + (size_t)(row0 + ai * HALF + m * 16) * (5 * D) + col0;
#pragma unroll
                for (int bj = 0; bj < 2; ++bj) { float v[8];
#pragma unroll
                    for (int n = 0; n < 2; ++n)
#pragma unroll
                        for (int j = 0; j < 4; ++j) { const float z = acc[ai][bj][m][n][j]; float o;
                            if (type == 0 || type == 2) o = fsilu(z); else if (type == 1) o = z; else o = om[bj][4 * n + j] * fsigmoid(-z);
                            v[4 * n + j] = o; }
                    u32x4 w; w.x = cvt_pk_bf16(v[0], v[1]); w.y = cvt_pk_bf16(v[2], v[3]); w.z = cvt_pk_bf16(v[4], v[5]); w.w = cvt_pk_bf16(v[6], v[7]);
                    *(u32x4*)(rowp + bj * HALF) = w; } }
    }
};
struct EpiMlIn {
    static constexpr bool PERM = true;
    bf16* O; float* gates; const float* gate_b;
    __device__ __forceinline__ void operator()(const Acc& acc, const Unit& u, int wr, int wc, int fr, int fq) const {
        const int row0 = u.pm * BM + wr * 64 + fr, type = u.pn >> 3;
        if (type < 4) {
            const int col0 = u.pn * BM + wc * 32 + 8 * fq;
#pragma unroll
            for (int ai = 0; ai < 2; ++ai)
#pragma unroll
                for (int m = 0; m < 4; ++m) { bf16* rowp = O + (size_t)(row0 + ai * HALF + m * 16) * (4 * D) + col0;
#pragma unroll
                    for (int bj = 0; bj < 2; ++bj) { float v[8];
#pragma unroll
                        for (int n = 0; n < 2; ++n)
#pragma unroll
                            for (int j = 0; j < 4; ++j) { const float z = acc[ai][bj][m][n][j]; v[4 * n + j] = type == 1 ? z * 0.0625f : (type == 3 ? fsigmoid(z) : z); }
                        u32x4 w; w.x = cvt_pk_bf16(v[0], v[1]); w.y = cvt_pk_bf16(v[2], v[3]); w.z = cvt_pk_bf16(v[4], v[5]); w.w = cvt_pk_bf16(v[6], v[7]);
                        *(u32x4*)(rowp + bj * HALF) = w; } }
        } else if (wc == 0) {
            float gb[8];
#pragma unroll
            for (int j = 0; j < 8; ++j) gb[j] = gate_b[8 * fq + j];
#pragma unroll
            for (int ai = 0; ai < 2; ++ai)
#pragma unroll
                for (int m = 0; m < 4; ++m) { float* gp = gates + (size_t)(row0 + ai * HALF + m * 16) * 32 + 8 * fq;
#pragma unroll
                    for (int n = 0; n < 2; ++n) { f32x4 o;
#pragma unroll
                        for (int j = 0; j < 4; ++j) { float z = acc[ai][0][m][n][j] + gb[4 * n + j];
                            if (fq & 1) z = fminf(z, 0.f) - log1pf(expf(-fabsf(z)));
                            o[j] = z; }
                        *(f32x4*)(gp + 4 * n) = o; } }
        }
    }
};
struct EpiS5Glu {
    static constexpr bool PERM = true;
    float* XZ; const float* modl; int gate_idx;
    __device__ __forceinline__ void operator()(const Acc& acc, const Unit& u, int wr, int wc, int fr, int fq) const {
        const int row0 = u.pm * BM + wr * 64 + fr, col0 = u.pn * HALF + wc * 32 + 8 * fq;
        const float* gp = modl + (size_t)(u.pm < RL / 256 ? (u.pm >> 4) : NB) * MODW + gate_idx * D + col0;
        const f32x4 g0 = *(const f32x4*)gp, g1 = *(const f32x4*)(gp + 4);
#pragma unroll
        for (int ai = 0; ai < 2; ++ai)
#pragma unroll
            for (int m = 0; m < 4; ++m) { float* rowp = XZ + (size_t)(row0 + ai * HALF + m * 16) * D + col0;
#pragma unroll
                for (int n = 0; n < 2; ++n) { f32x4 y;
#pragma unroll
                    for (int j = 0; j < 4; ++j) y[j] = acc[ai][0][m][n][j] * fsigmoid(acc[ai][1][m][n][j]);
                    f32x4* p = (f32x4*)(rowp + 4 * n); const f32x4 x = *p; *p = x * DN_ALPHA + (n ? g1 : g0) * y; } }
    }
};

__device__ __forceinline__ void transpose_item(const float* W, int N, bf16* WT, int ldk, int mode, int NH, LAS float* scr, int item, int lane) {
    const int nblk = N / 32, kb = item / nblk, nb = item % nblk, k0 = 64 * kb, n0 = 32 * nb;
#pragma unroll 8
    for (int i = 0; i < 32; ++i) { const int kk = 2 * i + (lane >> 5); scr[kk * 33 + (lane & 31)] = W[(size_t)(k0 + kk) * N + n0 + (lane & 31)]; }
    asm volatile("s_waitcnt lgkmcnt(0)" ::: "memory");
    int r0 = n0;
    if (mode == 1) { const int half = n0 / NH, j = n0 - half * NH; r0 = 256 * (j >> 7) + 128 * half + (j & 127); }
    const int c = lane & 7;
#pragma unroll
    for (int j = 0; j < 4; ++j) { const int n = (lane >> 3) + 8 * j; const LAS float* s = scr + (8 * c) * 33 + n;
        u32x4 o; o.x = cvt_pk_bf16(s[0 * 33], s[1 * 33]); o.y = cvt_pk_bf16(s[2 * 33], s[3 * 33]); o.z = cvt_pk_bf16(s[4 * 33], s[5 * 33]); o.w = cvt_pk_bf16(s[6 * 33], s[7 * 33]);
        *(u32x4*)(WT + (size_t)(r0 + n) * ldk + k0 + 8 * c) = o; }
    asm volatile("s_waitcnt lgkmcnt(0)" ::: "memory");
}
__device__ __forceinline__ void convert_ffn_layer(const float* w13a, const float* w2a, const float* w13b, const float* w2b, unsigned char* ws, LAS float* scr, int gw, int NGW, int lane) {
    constexpr int I13 = (D / 64) * (2 * FF / 32), I2 = (FF / 64) * (D / 32);
    for (int it = gw; it < 2 * (I13 + I2); it += NGW) {
        int r = it;
        if (r < I13) { transpose_item(w13a, 2 * FF, (bf16*)(ws + WS_W13A), D, 1, FF, scr, r, lane); continue; } r -= I13;
        if (r < I2) { transpose_item(w2a, D, (bf16*)(ws + WS_W2A), FF, 0, 0, scr, r, lane); continue; } r -= I2;
        if (r < I13) { transpose_item(w13b, 2 * FF, (bf16*)(ws + WS_W13B), D, 1, FF, scr, r, lane); continue; } r -= I13;
        transpose_item(w2b, D, (bf16*)(ws + WS_W2B), FF, 0, 0, scr, r, lane);
    }
}

template <int MODE>
__device__ __forceinline__ void row_phase(int gw, int NGW, int lane, int nrows, const float* xin, const float* ctxin, float* XZ, bf16* H,
                                          const float* lng, const float* lnb, const float* modl, int shift_idx, int scale_idx, float* out) {
    for (int r = gw; r < nrows; r += NGW) {
        const float* src = MODE == 0 ? (r < RL ? xin + (size_t)r * D : ctxin + (size_t)(r - RL) * D) : XZ + (size_t)r * D;
        f32x4 v[8];
#pragma unroll
        for (int j = 0; j < 8; ++j) v[j] = *(const f32x4*)(src + 4 * lane + 256 * j);
        if (MODE == 1) {
            float s = 0.f;
#pragma unroll
            for (int j = 0; j < 8; ++j) s += (v[j].x + v[j].y) + (v[j].z + v[j].w);
            const float mean = wave_sum(s) * (1.f / D); float s2 = 0.f;
#pragma unroll
            for (int j = 0; j < 8; ++j) { v[j] = v[j] - mean; s2 += (v[j].x * v[j].x + v[j].y * v[j].y) + (v[j].z * v[j].z + v[j].w * v[j].w); }
            const float rstd = 1.f / sqrtf(wave_sum(s2) * (1.f / D) + LN_EPS);
#pragma unroll
            for (int j = 0; j < 8; ++j) { const f32x4 gg = *(const f32x4*)(lng + 4 * lane + 256 * j), bb = *(const f32x4*)(lnb + 4 * lane + 256 * j); v[j] = v[j] * rstd * gg + bb; }
        }
#pragma unroll
        for (int j = 0; j < 8; ++j) *(f32x4*)(XZ + (size_t)r * D + 4 * lane + 256 * j) = v[j];
        if (out && r < RL) {
#pragma unroll
            for (int j = 0; j < 8; ++j) *(f32x4*)(out + (size_t)r * D + 4 * lane + 256 * j) = v[j];
        }
        if (H) {
            const float* mp = modl + (size_t)row_batch(r) * MODW;
#pragma unroll
            for (int j = 0; j < 8; ++j) { const int c = 4 * lane + 256 * j; const f32x4 sh = *(const f32x4*)(mp + shift_idx * D + c), sc = *(const f32x4*)(mp + scale_idx * D + c);
                const f32x4 h = v[j] * (sc + 1.0f) + sh; u32x2 w; w.x = cvt_pk_bf16(h.x, h.y); w.y = cvt_pk_bf16(h.z, h.w);
                *(u32x2*)(H + (size_t)r * D + c) = w; }
        }
    }
}
__device__ __forceinline__ void pool_phase(int gw, int NGW, int lane, const float* XZ, bf16* H, const float* modl, int scale_idx) {
    for (int r = gw; r < R; r += NGW) {
        int pos, n; if (r < RL) { pos = r & 63; n = 64; } else { pos = (r - RL) & 255; n = 256; }
        const int base = r - pos; const float* mp = modl + (size_t)row_batch(r) * MODW + scale_idx * D;
#pragma unroll
        for (int j = 0; j < 8; ++j) { const int c = 4 * lane + 256 * j, W = 2 << (j >> 1);
            int lo = pos - W / 2; lo = lo < 0 ? 0 : lo; int hi = pos + W - W / 2 - 1; hi = hi > n - 1 ? n - 1 : hi;
            f32x4 a = (f32x4){0.f, 0.f, 0.f, 0.f};
            for (int p = lo; p <= hi; ++p) a += *(const f32x4*)(XZ + (size_t)(base + p) * D + c);
            const f32x4 self = *(const f32x4*)(XZ + (size_t)r * D + c), sc = *(const f32x4*)(mp + c);
            const f32x4 h = (a * (1.0f / (float)(hi - lo + 1)) - self) * (sc + 1.0f);
            u32x2 w; w.x = cvt_pk_bf16(h.x, h.y); w.y = cvt_pk_bf16(h.z, h.w); *(u32x2*)(H + (size_t)r * D + c) = w; }
    }
}
template <int HD>
__device__ __forceinline__ void readout_phase(int gw, int NGW, int lane, const float* O1, const float* O2, const bf16* PROJ, int ldp, int gcol, const float* norm_g, bf16* H) {
    for (int r = gw; r < R; r += NGW) {
#pragma unroll
        for (int j = 0; j < 8; ++j) { const int c = 4 * lane + 256 * j;
            const f32x4 o = *(const f32x4*)(O1 + (size_t)r * D + c) + *(const f32x4*)(O2 + (size_t)r * D + c);
            float s = (o.x * o.x + o.y * o.y) + (o.z * o.z + o.w * o.w);
#pragma unroll
            for (int off = 1; off < (HD == 128 ? 32 : 64); off <<= 1) s += __shfl_xor(s, off);
            const float rs = 1.0f / sqrtf(s * (1.0f / HD) + RMS_EPS);
            const u32x2 gw2 = *(const u32x2*)(PROJ + (size_t)r * ldp + gcol + c); const f32x4 ng = *(const f32x4*)(norm_g + c);
            f32x4 h; h.x = o.x * rs * ng.x * bf_lo(gw2.x); h.y = o.y * rs * ng.y * bf_hi(gw2.x); h.z = o.z * rs * ng.z * bf_lo(gw2.y); h.w = o.w * rs * ng.w * bf_hi(gw2.y);
            u32x2 w; w.x = cvt_pk_bf16(h.x, h.y); w.y = cvt_pk_bf16(h.z, h.w); *(u32x2*)(H + (size_t)r * D + c) = w; }
    }
}
__device__ __forceinline__ void s5_readout_phase(int gw, int NGW, int lane, const float* Y1, const float* Y2, const float* XZ, const float* dskip, const float* modl, int shift_idx, int scale_idx, bf16* H) {
    for (int r = gw; r < R; r += NGW) {
        const float* mp = modl + (size_t)row_batch(r) * MODW;
#pragma unroll
        for (int j = 0; j < 8; ++j) { const int c = 4 * lane + 256 * j;
            const f32x4 x = *(const f32x4*)(XZ + (size_t)r * D + c), sh = *(const f32x4*)(mp + shift_idx * D + c), sc = *(const f32x4*)(mp + scale_idx * D + c), dk = *(const f32x4*)(dskip + c);
            const f32x4 y = *(const f32x4*)(Y1 + (size_t)r * D + c) + *(const f32x4*)(Y2 + (size_t)r * D + c) + dk * (x * (sc + 1.0f) + sh);
            u32x2 w; w.x = cvt_pk_bf16(gelu_tanh(y.x), gelu_tanh(y.y)); w.y = cvt_pk_bf16(gelu_tanh(y.z), gelu_tanh(y.w)); *(u32x2*)(H + (size_t)r * D + c) = w; }
    }
}

__device__ __forceinline__ void hgrn_scan(LAS unsigned char* lds, const bf16* PROJ, float* Of, float* Ob, int tid) {
    constexpr int TB = 16, QS = 144, LDP = 5 * D;
    LAS float* qs = (LAS float*)lds;
    LAS float* ks = qs + 2 * TB * QS;
    LAS float* vs = ks + 2 * TB * QS;
    const int lane = tid & 63, w = tid >> 6, vloc = lane >> 2, kq = lane & 3, v = 16 * w + vloc;
    const int sA = (tid >> 4) & 15, arrA = tid >> 8, chunk = tid & 15;
    for (int seq = blockIdx.x; seq < NB * 16 * 2; seq += gridDim.x) {
        const int d = seq & 1, head = (seq >> 1) & 15, b = seq >> 5;
        float* O = d ? Ob : Of;
        const int colA = (arrA == 0 ? head * 128 : 3 * D + d * D + head * 128) + chunk * 8, colV = D + head * 128 + chunk * 8;
        f32x2 S[16];
#pragma unroll
        for (int j = 0; j < 16; ++j) S[j] = (f32x2){0.f, 0.f};
        u32x4 ra, rv = (u32x4){0u, 0u, 0u, 0u};
        ra = *(const u32x4*)(PROJ + (size_t)scan_row(b, d, sA) * LDP + colA);
        if (tid < 256) rv = *(const u32x4*)(PROJ + (size_t)scan_row(b, d, sA) * LDP + colV);
        __syncthreads();
#define HG_WRITE(buf) do { LAS float* dq = (arrA ? ks : qs) + ((buf) * TB + sA) * QS + chunk * 8 + 4 * (chunk >> 2); \
            *(LAS f32x4*)dq = (f32x4){bf_lo(ra.x), bf_hi(ra.x), bf_lo(ra.y), bf_hi(ra.y)}; *(LAS f32x4*)(dq + 4) = (f32x4){bf_lo(ra.z), bf_hi(ra.z), bf_lo(ra.w), bf_hi(ra.w)}; \
            if (tid < 256) { LAS float* dv = vs + ((buf) * TB + sA) * 128 + chunk * 8; \
                *(LAS f32x4*)dv = (f32x4){bf_lo(rv.x), bf_hi(rv.x), bf_lo(rv.y), bf_hi(rv.y)}; *(LAS f32x4*)(dv + 4) = (f32x4){bf_lo(rv.z), bf_hi(rv.z), bf_lo(rv.w), bf_hi(rv.w)}; } } while (0)
        HG_WRITE(0);
        __syncthreads();
        for (int nb = 0; nb < NSTEP / TB; ++nb) {
            const int buf = nb & 1;
            if (nb + 1 < NSTEP / TB) { const size_t ro = (size_t)scan_row(b, d, (nb + 1) * TB + sA) * LDP; ra = *(const u32x4*)(PROJ + ro + colA); if (tid < 256) rv = *(const u32x4*)(PROJ + ro + colV); }
            for (int s = 0; s < TB; ++s) {
                const LAS f32x4* q4 = (const LAS f32x4*)(qs + (buf * TB + s) * QS + kq * 36);
                const LAS f32x4* k4 = (const LAS f32x4*)(ks + (buf * TB + s) * QS + kq * 36);
                const float vv = vs[(buf * TB + s) * 128 + v];
                f32x2 o2 = (f32x2){0.f, 0.f};
#pragma unroll
                for (int jj = 0; jj < 8; ++jj) { const f32x4 q = q4[jj], k = k4[jj];
                    const f32x2 k01 = (f32x2){k.x, k.y}, k23 = (f32x2){k.z, k.w}, q01 = (f32x2){q.x, q.y}, q23 = (f32x2){q.z, q.w};
                    S[2 * jj] = (1.0f - k01) * S[2 * jj] + k01 * vv; o2 += q01 * S[2 * jj];
                    S[2 * jj + 1] = (1.0f - k23) * S[2 * jj + 1] + k23 * vv; o2 += q23 * S[2 * jj + 1]; }
                float o = o2.x + o2.y; o += __shfl_xor(o, 1); o += __shfl_xor(o, 2);
                if (kq == 0) O[(size_t)scan_row(b, d, nb * TB + s) * D + head * 128 + v] = o;
            }
            if (nb + 1 < NSTEP / TB) HG_WRITE(buf ^ 1);
            __syncthreads();
        }
#undef HG_WRITE
    }
}
__device__ __forceinline__ void mlstm_scan(LAS unsigned char* lds, const bf16* PROJ, const float* gates, float* Hf, float* Hb, int tid) {
    constexpr int TB = 16, QS = 272, LDP = 4 * D;
    LAS float* qs = (LAS float*)lds;
    LAS float* ks = qs + 2 * TB * QS;
    LAS float* vs = ks + 2 * TB * QS;
    LAS float* gs = vs + 2 * TB * 128;
    const int lane = tid & 63, w = tid >> 6, vloc = lane >> 2, kq = lane & 3;
    const int sQ = tid >> 5, chQ = tid & 31, sV = (tid >> 4) & 15, chV = tid & 15, sG = (tid >> 1) & 15, whG = tid & 1;
    for (int seq = blockIdx.x; seq < NB * 8 * 2 * 2; seq += gridDim.x) {
        const int vh = seq & 1, d = (seq >> 1) & 1, head = (seq >> 2) & 7, b = seq >> 5;
        float* Hd = d ? Hb : Hf;
        const int colQ = head * 256 + chQ * 8, colK = D + head * 256 + chQ * 8, colV = 2 * D + head * 256 + vh * 128 + chV * 8, colG = d * 16 + whG * 8 + head;
        f32x2 C[32];
#pragma unroll
        for (int j = 0; j < 32; ++j) C[j] = (f32x2){0.f, 0.f};
        f32x4 n4 = (f32x4){0.f, 0.f, 0.f, 0.f}; float mst = 0.f;
        u32x4 rq, rk, rv = (u32x4){0u, 0u, 0u, 0u}; float rg = 0.f;
        { const size_t ro = (size_t)scan_row(b, d, sQ) * LDP; rq = *(const u32x4*)(PROJ + ro + colQ); rk = *(const u32x4*)(PROJ + ro + colK); }
        if (tid < 256) rv = *(const u32x4*)(PROJ + (size_t)scan_row(b, d, sV) * LDP + colV);
        if (tid < 32) rg = gates[(size_t)scan_row(b, d, sG) * 32 + colG];
        __syncthreads();
#define ML_W8(dst, r) do { *(LAS f32x4*)(dst) = (f32x4){bf_lo(r.x), bf_hi(r.x), bf_lo(r.y), bf_hi(r.y)}; *(LAS f32x4*)((dst) + 4) = (f32x4){bf_lo(r.z), bf_hi(r.z), bf_lo(r.w), bf_hi(r.w)}; } while (0)
#define ML_WRITE(buf) do { ML_W8(qs + ((buf) * TB + sQ) * QS + chQ * 8 + 4 * (chQ >> 3), rq); ML_W8(ks + ((buf) * TB + sQ) * QS + chQ * 8 + 4 * (chQ >> 3), rk); \
            if (tid < 256) ML_W8(vs + ((buf) * TB + sV) * 128 + chV * 8, rv); if (tid < 32) gs[((buf) * TB + sG) * 2 + whG] = rg; } while (0)
        ML_WRITE(0);
        __syncthreads();
        for (int nb = 0; nb < NSTEP / TB; ++nb) {
            const int buf = nb & 1;
            if (nb + 1 < NSTEP / TB) { const int n1 = (nb + 1) * TB; const size_t ro = (size_t)scan_row(b, d, n1 + sQ) * LDP; rq = *(const u32x4*)(PROJ + ro + colQ); rk = *(const u32x4*)(PROJ + ro + colK);
                if (tid < 256) rv = *(const u32x4*)(PROJ + (size_t)scan_row(b, d, n1 + sV) * LDP + colV); if (tid < 32) rg = gates[(size_t)scan_row(b, d, n1 + sG) * 32 + colG]; }
            for (int s = 0; s < TB; ++s) {
                const float logi = gs[(buf * TB + s) * 2], logf = gs[(buf * TB + s) * 2 + 1];
                const float mnew = fmaxf(logf + mst, logi), fd = __expf(logf + mst - mnew), iw = __expf(logi - mnew); mst = mnew;
                const LAS f32x4* q4 = (const LAS f32x4*)(qs + (buf * TB + s) * QS + kq * 68);
                const LAS f32x4* k4 = (const LAS f32x4*)(ks + (buf * TB + s) * QS + kq * 68);
                const float ikv = iw * vs[(buf * TB + s) * 128 + 16 * w + vloc];
                f32x2 o2 = (f32x2){0.f, 0.f};
#pragma unroll
                for (int jj = 0; jj < 16; ++jj) { const f32x4 q = q4[jj], k = k4[jj];
                    const f32x2 k01 = (f32x2){k.x, k.y}, k23 = (f32x2){k.z, k.w}, q01 = (f32x2){q.x, q.y}, q23 = (f32x2){q.z, q.w};
                    C[2 * jj] = fd * C[2 * jj] + k01 * ikv; o2 += q01 * C[2 * jj];
                    C[2 * jj + 1] = fd * C[2 * jj + 1] + k23 * ikv; o2 += q23 * C[2 * jj + 1]; }
                float num = o2.x + o2.y; num += __shfl_xor(num, 1); num += __shfl_xor(num, 2);
                const int po = 4 * lane + 4 * (lane >> 4);
                const f32x4 kn = *(const LAS f32x4*)(ks + (buf * TB + s) * QS + po), qn = *(const LAS f32x4*)(qs + (buf * TB + s) * QS + po);
                n4 = fd * n4 + iw * kn;
                const float den = wave_sum((qn.x * n4.x + qn.y * n4.y) + (qn.z * n4.z + qn.w * n4.w));
                const float hval = num / fmaxf(fabsf(den), __expf(-mst));
                if (kq == 0) Hd[(size_t)scan_row(b, d, nb * TB + s) * D + head * 256 + vh * 128 + 16 * w + vloc] = hval;
            }
            if (nb + 1 < NSTEP / TB) ML_WRITE(buf ^ 1);
            __syncthreads();
        }
#undef ML_WRITE
#undef ML_W8
    }
}
__device__ __forceinline__ void s5_scan(LAS unsigned char* lds, const float* XZ, const float* modl, int shift_idx, int scale_idx,
                                        const float* abar, const float* bbar, const float* cre, const float* cim, float* Yf, float* Yb, int tid) {
    constexpr int TB = 32;
    const int lane = tid & 63, w = tid >> 6;
    LAS float* us = (LAS float*)lds + w * (2 * TB * 16);
    const int sL = lane >> 1, hL = lane & 1;
    for (int seq = blockIdx.x * 8 + w; seq < NB * 128 * 2; seq += gridDim.x * 8) {
        const int d = seq & 1, g = (seq >> 1) & 127, b = seq >> 8;
        float* Y = d ? Yb : Yf;
        const float ar = abar[(d * 128 + g) * 64 + lane], ai = abar[2 * 128 * 64 + (d * 128 + g) * 64 + lane];
        float bbr[16], bbi[16], cr[16], ci[16];
#pragma unroll
        for (int i = 0; i < 16; ++i) { bbr[i] = bbar[((size_t)(d * 128 + g) * 64 + lane) * 16 + i]; bbi[i] = bbar[(size_t)2 * 128 * 64 * 16 + ((size_t)(d * 128 + g) * 64 + lane) * 16 + i];
            cr[i] = cre[((size_t)(d * 128 + g) * 16 + i) * 64 + lane]; ci[i] = cim[((size_t)(d * 128 + g) * 16 + i) * 64 + lane]; }
        const int cL = g * 16 + hL * 8;
        f32x4 sc0, sc1, sh0, sh1, sc0c, sc1c, sh0c, sh1c;
        { const float* mp = modl + (size_t)b * MODW; sc0 = *(const f32x4*)(mp + scale_idx * D + cL) + 1.0f; sc1 = *(const f32x4*)(mp + scale_idx * D + cL + 4) + 1.0f; sh0 = *(const f32x4*)(mp + shift_idx * D + cL); sh1 = *(const f32x4*)(mp + shift_idx * D + cL + 4);
          const float* mc = modl + (size_t)NB * MODW; sc0c = *(const f32x4*)(mc + scale_idx * D + cL) + 1.0f; sc1c = *(const f32x4*)(mc + scale_idx * D + cL + 4) + 1.0f; sh0c = *(const f32x4*)(mc + shift_idx * D + cL); sh1c = *(const f32x4*)(mc + shift_idx * D + cL + 4); }
        float xr = 0.f, xi = 0.f;
        f32x4 r0, r1;
        { const float* p = XZ + (size_t)scan_row(b, d, sL) * D + cL; r0 = *(const f32x4*)p; r1 = *(const f32x4*)(p + 4); }
#define S5_WRITE(buf, isctx) do { LAS float* du = us + ((buf) * TB + sL) * 16 + hL * 8; \
            *(LAS f32x4*)du = (isctx) ? r0 * sc0c + sh0c : r0 * sc0 + sh0; *(LAS f32x4*)(du + 4) = (isctx) ? r1 * sc1c + sh1c : r1 * sc1 + sh1; } while (0)
        S5_WRITE(0, true);
        __builtin_amdgcn_wave_barrier(); asm volatile("s_waitcnt lgkmcnt(0)" ::: "memory");
        for (int nb = 0; nb < NSTEP / TB; ++nb) {
            const int buf = nb & 1;
            if (nb + 1 < NSTEP / TB) { const float* p = XZ + (size_t)scan_row(b, d, (nb + 1) * TB + sL) * D + cL; r0 = *(const f32x4*)p; r1 = *(const f32x4*)(p + 4); }
            for (int s = 0; s < TB; ++s) {
                const LAS f32x4* u4 = (const LAS f32x4*)(us + (buf * TB + s) * 16);
                float bur = 0.f, bui = 0.f;
#pragma unroll
                for (int q = 0; q < 4; ++q) { const f32x4 u = u4[q];
                    bur += bbr[4 * q] * u.x + bbr[4 * q + 1] * u.y + bbr[4 * q + 2] * u.z + bbr[4 * q + 3] * u.w;
                    bui += bbi[4 * q] * u.x + bbi[4 * q + 1] * u.y + bbi[4 * q + 2] * u.z + bbi[4 * q + 3] * u.w; }
                const float nxr = ar * xr - ai * xi + bur, nxi = ar * xi + ai * xr + bui; xr = nxr; xi = nxi;
                float yv[16];
#pragma unroll
                for (int i = 0; i < 16; ++i) yv[i] = cr[i] * xr - ci[i] * xi;
                float r8[8], r4[4], r2[2], r1v;
                { const bool hi = lane & 32;
#pragma unroll
                  for (int j = 0; j < 8; ++j) { const float send = hi ? yv[j] : yv[j + 8], keep = hi ? yv[j + 8] : yv[j]; r8[j] = keep + __shfl_xor(send, 32); } }
                { const bool hi = lane & 16;
#pragma unroll
                  for (int j = 0; j < 4; ++j) { const float send = hi ? r8[j] : r8[j + 4], keep = hi ? r8[j + 4] : r8[j]; r4[j] = keep + __shfl_xor(send, 16); } }
                { const bool hi = lane & 8;
#pragma unroll
                  for (int j = 0; j < 2; ++j) { const float send = hi ? r4[j] : r4[j + 2], keep = hi ? r4[j + 2] : r4[j]; r2[j] = keep + __shfl_xor(send, 8); } }
                { const bool hi = lane & 4; const float send = hi ? r2[0] : r2[1], keep = hi ? r2[1] : r2[0]; r1v = keep + __shfl_xor(send, 4); }
                r1v += __shfl_xor(r1v, 1); r1v += __shfl_xor(r1v, 2);
                const int oi = ((lane >> 5) & 1) * 8 + ((lane >> 4) & 1) * 4 + ((lane >> 3) & 1) * 2 + ((lane >> 2) & 1);
                if ((lane & 3) == 0) Y[(size_t)scan_row(b, d, nb * TB + s) * D + g * 16 + oi] = r1v;
            }
            if (nb + 1 < NSTEP / TB) { const bool isctx = (nb + 1) * TB < CT; S5_WRITE(buf ^ 1, isctx); }
            __builtin_amdgcn_wave_barrier(); asm volatile("s_waitcnt lgkmcnt(0)" ::: "memory");
        }
#undef S5_WRITE
    }
}


typedef float f32x16 __attribute__((ext_vector_type(16)));
typedef __bf16 bf16v2 __attribute__((ext_vector_type(2)));
__device__ __forceinline__ unsigned pkbf(float lo, float hi) { const f32x2 v = {lo, hi}; return __builtin_bit_cast(unsigned, __builtin_convertvector(v, bf16v2)); }
__device__ __forceinline__ bf16x8 pack8(const float* p, float sgn) {
    u32x4 w; w.x = pkbf(sgn * p[0], sgn * p[1]); w.y = pkbf(sgn * p[2], sgn * p[3]); w.z = pkbf(sgn * p[4], sgn * p[5]); w.w = pkbf(sgn * p[6], sgn * p[7]); return __builtin_bit_cast(bf16x8, w); }
__device__ __forceinline__ void s5_scan_mfma(LAS unsigned char* lds, const bf16* H, const float* abar, const float* bbar, const float* cre, const float* cim, float* Yf, float* Yb, int tid) {
    constexpr int XS = 272;
    const int lane = tid & 63, w = tid >> 6, r = lane & 31, h = lane >> 5, li = lane & 15, gq = lane >> 4;
    LAS unsigned char* xt = lds + w * (32 * XS);
    for (int seq = blockIdx.x * 8 + w; seq < NB * 128 * 2; seq += gridDim.x * 8) {
        const int d = seq & 1, g = (seq >> 1) & 127, b = seq >> 8, dg = d * 128 + g;
        float* Y = d ? Yb : Yf;
        const float ar = abar[dg * 64 + lane], ai = abar[2 * 128 * 64 + dg * 64 + lane];
        bf16x8 fb[4], fc[4];
#pragma unroll
        for (int tl = 0; tl < 4; ++tl) fb[tl] = pack8(bbar + (size_t)(tl >> 1) * (2 * 128 * 64 * 16) + ((size_t)dg * 64 + (tl & 1) * 32 + r) * 16 + 8 * h, 1.0f);
#pragma unroll
        for (int s = 0; s < 4; ++s) fc[s] = pack8((s < 2 ? cre : cim) + ((size_t)dg * 16 + li) * 64 + 32 * (s & 1) + 8 * gq, s < 2 ? 1.0f : -1.0f);
        float xr = 0.f, xi = 0.f;
        u32x4 ua = *(const u32x4*)(H + (size_t)scan_row(b, d, r) * D + g * 16 + 8 * h);
        for (int nb = 0; nb < NSTEP / 32; ++nb) {
            const bf16x8 fa = __builtin_bit_cast(bf16x8, ua);
            if (nb + 1 < NSTEP / 32) ua = *(const u32x4*)(H + (size_t)scan_row(b, d, (nb + 1) * 32 + r) * D + g * 16 + 8 * h);
            f32x16 z16;
#pragma unroll
            for (int j = 0; j < 16; ++j) z16[j] = 0.f;
            f32x16 c0 = __builtin_amdgcn_mfma_f32_32x32x16_bf16(fa, fb[0], z16, 0, 0, 0);
            f32x16 c1 = __builtin_amdgcn_mfma_f32_32x32x16_bf16(fa, fb[1], z16, 0, 0, 0);
            f32x16 c2 = __builtin_amdgcn_mfma_f32_32x32x16_bf16(fa, fb[2], z16, 0, 0, 0);
            f32x16 c3 = __builtin_amdgcn_mfma_f32_32x32x16_bf16(fa, fb[3], z16, 0, 0, 0);
#pragma unroll
            for (int j = 0; j < 16; ++j) {
                auto rr = __builtin_amdgcn_permlane32_swap(__float_as_uint(c0[j]), __float_as_uint(c1[j]), false, false); c0[j] = __uint_as_float(rr[0]); c1[j] = __uint_as_float(rr[1]);
                auto ri = __builtin_amdgcn_permlane32_swap(__float_as_uint(c2[j]), __float_as_uint(c3[j]), false, false); c2[j] = __uint_as_float(ri[0]); c3[j] = __uint_as_float(ri[1]);
            }
#define S5_STEP(bur, bui, t) do { const float nxr = ar * xr - ai * xi + (bur), nxi = ar * xi + ai * xr + (bui); xr = nxr; xi = nxi; \
                const unsigned pw = pkbf(xr, xi); *(LAS unsigned short*)(xt + (t) * XS + 2 * lane) = (unsigned short)pw; *(LAS unsigned short*)(xt + (t) * XS + 128 + 2 * lane) = (unsigned short)(pw >> 16); } while (0)
#pragma unroll
            for (int jj = 0; jj < 4; ++jj) {
#pragma unroll
                for (int q = 0; q < 4; ++q) S5_STEP(c0[4 * jj + q], c2[4 * jj + q], 8 * jj + q);
#pragma unroll
                for (int q = 0; q < 4; ++q) S5_STEP(c1[4 * jj + q], c3[4 * jj + q], 8 * jj + 4 + q);
            }
#undef S5_STEP
            asm volatile("s_waitcnt lgkmcnt(0)" ::: "memory"); __builtin_amdgcn_wave_barrier();
#pragma unroll
            for (int tb = 0; tb < 2; ++tb) {
                f32x4 acc = (f32x4){0.f, 0.f, 0.f, 0.f};
#pragma unroll
                for (int s = 0; s < 4; ++s) { const bf16x8 xb = *(const LAS bf16x8*)(xt + (16 * tb + li) * XS + (32 * s + 8 * gq) * 2); acc = __builtin_amdgcn_mfma_f32_16x16x32_bf16(fc[s], xb, acc, 0, 0, 0); }
                *(f32x4*)(Y + (size_t)scan_row(b, d, nb * 32 + 16 * tb + li) * D + g * 16 + 4 * gq) = acc;
            }
            asm volatile("s_waitcnt lgkmcnt(0)" ::: "memory"); __builtin_amdgcn_wave_barrier();
        }
    }
}


__device__ __forceinline__ unsigned short lds_u16(const LAS unsigned char* p) { return *(const LAS unsigned short*)p; }
__device__ __forceinline__ void hgrn_scan_mfma(LAS unsigned char* lds, const bf16* PROJ, float* Of, float* Ob, int tid) {
    constexpr int LDP = 5 * D, NCH = NSTEP / 32;
    constexpr int O_RQ = 0, O_RK = 8192, O_RV = 16384, O_QE = 24576, O_KE = 33280, O_KD = 41984, O_VT = 52224, O_ATT = 62464, O_DEC = 65024, O_PART = 65536, O_ST = 67584;
    const int lane = tid & 63, w = __builtin_amdgcn_readfirstlane(tid >> 6), li = lane & 15, gq = lane >> 4, r = lane & 31, h = lane >> 5;
    const int pk = tid & 127, ptg = tid >> 7;
    const int lt = tid >> 4, lch = tid & 15;
    for (int seq = blockIdx.x; seq < NB * 16 * 2; seq += gridDim.x) {
        const int d = seq & 1, head = (seq >> 1) & 15, b = seq >> 5;
        float* O = d ? Ob : Of;
        const int colQ = head * 128 + 8 * lch, colK = 3 * D + d * D + head * 128 + 8 * lch, colV = D + head * 128 + 8 * lch;
        f32x16 S0, S1;
#pragma unroll
        for (int j = 0; j < 16; ++j) { S0[j] = 0.f; S1[j] = 0.f; }
        u32x4 rq, rk, rv;
        { const size_t ro = (size_t)scan_row(b, d, lt) * LDP; rq = *(const u32x4*)(PROJ + ro + colQ); rk = *(const u32x4*)(PROJ + ro + colK); rv = *(const u32x4*)(PROJ + ro + colV); }
        __syncthreads();
        for (int i = tid; i < 34816 / 16; i += 512) *(LAS u32x4*)(lds + O_ST + 16 * i) = (u32x4){0u, 0u, 0u, 0u};
        *(LAS u32x4*)(lds + O_RQ + lt * 256 + 16 * lch) = rq; *(LAS u32x4*)(lds + O_RK + lt * 256 + 16 * lch) = rk; *(LAS u32x4*)(lds + O_RV + lt * 256 + 16 * lch) = rv;
        __syncthreads();
        for (int c = 0; c < NCH; ++c) {
            if (c + 1 < NCH) { const size_t ro = (size_t)scan_row(b, d, (c + 1) * 32 + lt) * LDP; rq = *(const u32x4*)(PROJ + ro + colQ); rk = *(const u32x4*)(PROJ + ro + colK); rv = *(const u32x4*)(PROJ + ro + colV); }
            float kkv[8], cs[8]; float run = 0.f;
#pragma unroll
            for (int j = 0; j < 8; ++j) { const float kk = __uint_as_float((unsigned)lds_u16(lds + O_RK + (8 * ptg + j) * 256 + 2 * pk) << 16); kkv[j] = kk; run += __logf(1.0f - kk); cs[j] = run; }
            ((LAS float*)(lds + O_PART))[ptg * 128 + pk] = run;
            __syncthreads();
            {
                const LAS float* pp = (const LAS float*)(lds + O_PART) + pk;
                const float p0 = pp[0], p1 = pp[128], p2 = pp[256], p3 = pp[384];
                const float pre = (ptg > 0 ? p0 : 0.f) + (ptg > 1 ? p1 : 0.f) + (ptg > 2 ? p2 : 0.f), bL = (p0 + p1) + (p2 + p3);
                float kdv[8]; unsigned short vraw[8];
#pragma unroll
                for (int j = 0; j < 8; ++j) { const int t = 8 * ptg + j; const float bt = pre + cs[j];
                    const float q = __uint_as_float((unsigned)lds_u16(lds + O_RQ + t * 256 + 2 * pk) << 16);
                    const unsigned pw = pkbf(q * __expf(bt), kkv[j] * __expf(-bt));
                    *(LAS unsigned short*)(lds + O_QE + t * 272 + 2 * pk) = (unsigned short)pw; *(LAS unsigned short*)(lds + O_KE + t * 272 + 2 * pk) = (unsigned short)(pw >> 16);
                    kdv[j] = kkv[j] * __expf(bL - bt); vraw[j] = lds_u16(lds + O_RV + t * 256 + 2 * pk); }
                u32x4 wk; wk.x = pkbf(kdv[0], kdv[1]); wk.y = pkbf(kdv[2], kdv[3]); wk.z = pkbf(kdv[4], kdv[5]); wk.w = pkbf(kdv[6], kdv[7]);
                *(LAS u32x4*)(lds + O_KD + pk * 80 + 16 * ptg) = wk;
                u32x4 wv; wv.x = vraw[0] | ((unsigned)vraw[1] << 16); wv.y = vraw[2] | ((unsigned)vraw[3] << 16); wv.z = vraw[4] | ((unsigned)vraw[5] << 16); wv.w = vraw[6] | ((unsigned)vraw[7] << 16);
                *(LAS u32x4*)(lds + O_VT + pk * 80 + 16 * ptg) = wv;
                if (ptg == 0) ((LAS float*)(lds + O_DEC))[pk] = __expf(bL);
            }
            __syncthreads();
            if (c + 1 < NCH) { *(LAS u32x4*)(lds + O_RQ + lt * 256 + 16 * lch) = rq; *(LAS u32x4*)(lds + O_RK + lt * 256 + 16 * lch) = rk; *(LAS u32x4*)(lds + O_RV + lt * 256 + 16 * lch) = rv; }
            if (w < 4) {
                const int mi = w >> 1, ti = w & 1;
                u32x2 pw = (u32x2){0u, 0u};
                if (w != 2) {
                    f32x4 acc = (f32x4){0.f, 0.f, 0.f, 0.f};
#pragma unroll
                    for (int s = 0; s < 4; ++s) { const bf16x8 fa = *(const LAS bf16x8*)(lds + O_KE + (16 * mi + li) * 272 + (32 * s + 8 * gq) * 2), fbq = *(const LAS bf16x8*)(lds + O_QE + (16 * ti + li) * 272 + (32 * s + 8 * gq) * 2);
                        acc = __builtin_amdgcn_mfma_f32_16x16x32_bf16(fa, fbq, acc, 0, 0, 0); }
                    const int mb = 16 * mi + 4 * gq, tt = 16 * ti + li;
                    pw.x = pkbf(mb <= tt ? acc[0] : 0.f, mb + 1 <= tt ? acc[1] : 0.f); pw.y = pkbf(mb + 2 <= tt ? acc[2] : 0.f, mb + 3 <= tt ? acc[3] : 0.f);
                }
                *(LAS u32x2*)(lds + O_ATT + (16 * ti + li) * 80 + (16 * mi + 4 * gq) * 2) = pw;
            }
            __syncthreads();
#pragma unroll
            for (int ti = 0; ti < 2; ++ti) {
                f32x4 acc = (f32x4){0.f, 0.f, 0.f, 0.f};
                { const bf16x8 fa = *(const LAS bf16x8*)(lds + O_ATT + (16 * ti + li) * 80 + 16 * gq), fbv = *(const LAS bf16x8*)(lds + O_VT + (16 * w + li) * 80 + 16 * gq);
                  acc = __builtin_amdgcn_mfma_f32_16x16x32_bf16(fa, fbv, acc, 0, 0, 0); }
#pragma unroll
                for (int s = 0; s < 4; ++s) { const bf16x8 fa = *(const LAS bf16x8*)(lds + O_QE + (16 * ti + li) * 272 + (32 * s + 8 * gq) * 2), fbs = *(const LAS bf16x8*)(lds + O_ST + (16 * w + li) * 272 + (32 * s + 8 * gq) * 2);
                    acc = __builtin_amdgcn_mfma_f32_16x16x32_bf16(fa, fbs, acc, 0, 0, 0); }
#pragma unroll
                for (int q = 0; q < 4; ++q) O[(size_t)scan_row(b, d, c * 32 + 16 * ti + 4 * gq + q) * D + head * 128 + 16 * w + li] = acc[q];
            }
            const int vj = w & 3;
#pragma unroll
            for (int kk2 = 0; kk2 < 2; ++kk2) {
                const int ki = 2 * (w >> 2) + kk2;
                f32x16 S = kk2 ? S1 : S0;
#pragma unroll
                for (int jj = 0; jj < 4; ++jj) { const f32x4 d4 = *(const LAS f32x4*)(lds + O_DEC + (32 * ki + 8 * jj + 4 * h) * 4); S[4 * jj] *= d4.x; S[4 * jj + 1] *= d4.y; S[4 * jj + 2] *= d4.z; S[4 * jj + 3] *= d4.w; }
#pragma unroll
                for (int s = 0; s < 2; ++s) { const bf16x8 fa = *(const LAS bf16x8*)(lds + O_KD + (32 * ki + r) * 80 + (16 * s + 8 * h) * 2), fbv = *(const LAS bf16x8*)(lds + O_VT + (32 * vj + r) * 80 + (16 * s + 8 * h) * 2);
                    S = __builtin_amdgcn_mfma_f32_32x32x16_bf16(fa, fbv, S, 0, 0, 0); }
                if (kk2) S1 = S; else S0 = S;
            }
            __syncthreads();
#pragma unroll
            for (int kk2 = 0; kk2 < 2; ++kk2) { const int ki = 2 * (w >> 2) + kk2; const f32x16 S = kk2 ? S1 : S0;
#pragma unroll
                for (int jj = 0; jj < 4; ++jj) { u32x2 pw; pw.x = pkbf(S[4 * jj], S[4 * jj + 1]); pw.y = pkbf(S[4 * jj + 2], S[4 * jj + 3]);
                    *(LAS u32x2*)(lds + O_ST + (32 * vj + r) * 272 + (32 * ki + 8 * jj + 4 * h) * 2) = pw; } }
        }
    }
}


__device__ __forceinline__ void mlstm_scan_mfma(LAS unsigned char* lds, const bf16* PROJ, const float* gates, float* Hf, float* Hb, int tid) {
    constexpr int LDP = 4 * D, NCH = NSTEP / 32, QS = 528;
    constexpr int O_Q = 0, O_K = 16896, O_RV = 33792, O_VT = 41984, O_KWT = 52224, O_ATT = 72704, O_SC = 75264, O_NV = 77312, O_PQ = 78336;
    enum { S_GI = 0, S_GF = 32, S_AS = 64, S_BT = 96, S_WINT = 128, S_WLAST = 160, S_EMT = 192, S_DENP = 224, S_QN = 288, S_M = 320, S_DEC = 321 };
    LAS float* sc = (LAS float*)(lds + O_SC); LAS float* nv = (LAS float*)(lds + O_NV);
    const int lane = tid & 63, w = __builtin_amdgcn_readfirstlane(tid >> 6), li = lane & 15, gq = lane >> 4, r = lane & 31, h = lane >> 5;
    const int lt = tid >> 4, lch = tid & 15;
    for (int seq = blockIdx.x; seq < NB * 8 * 2 * 2; seq += gridDim.x) {
        const int vh = seq & 1, d = (seq >> 1) & 1, head = (seq >> 2) & 7, b = seq >> 5;
        float* Hd = d ? Hb : Hf;
        const int colQ = head * 256 + 8 * lch, colK = D + head * 256 + 8 * lch, colV = 2 * D + head * 256 + vh * 128 + 8 * lch, colG = d * 16 + (tid & 1) * 8 + head;
        f32x16 C0, C1, C2, C3;
#pragma unroll
        for (int j = 0; j < 16; ++j) { C0[j] = 0.f; C1[j] = 0.f; C2[j] = 0.f; C3[j] = 0.f; }
        u32x4 rq0, rq1, rk0, rk1, rv; float rg = 0.f;
#define ML_LOAD(n0) do { const size_t ro = (size_t)scan_row(b, d, (n0) + lt) * LDP; rq0 = *(const u32x4*)(PROJ + ro + colQ); rq1 = *(const u32x4*)(PROJ + ro + colQ + 128); \
            rk0 = *(const u32x4*)(PROJ + ro + colK); rk1 = *(const u32x4*)(PROJ + ro + colK + 128); rv = *(const u32x4*)(PROJ + ro + colV); \
            if (tid < 64) rg = gates[(size_t)scan_row(b, d, (n0) + (tid >> 1)) * 32 + colG]; } while (0)
#define ML_STORE() do { *(LAS u32x4*)(lds + O_Q + lt * QS + 16 * lch) = rq0; *(LAS u32x4*)(lds + O_Q + lt * QS + 256 + 16 * lch) = rq1; \
            *(LAS u32x4*)(lds + O_K + lt * QS + 16 * lch) = rk0; *(LAS u32x4*)(lds + O_K + lt * QS + 256 + 16 * lch) = rk1; *(LAS u32x4*)(lds + O_RV + lt * 256 + 16 * lch) = rv; \
            if (tid < 64) sc[((tid & 1) ? S_GF : S_GI) + (tid >> 1)] = rg; } while (0)
        ML_LOAD(0);
        __syncthreads();
        if (tid < 256) nv[tid] = 0.f;
        if (tid == 0) sc[S_M] = 0.f;
        ML_STORE();
        __syncthreads();
        for (int c = 0; c < NCH; ++c) {
            if (c + 1 < NCH) ML_LOAD((c + 1) * 32);
            if (w == 0) {
                const int t = lane & 31;
                const float lf = sc[S_GF + t], gi = sc[S_GI + t], mprev = sc[S_M];
                float bc = lf;
#pragma unroll
                for (int off = 1; off < 32; off <<= 1) { const float o = __shfl_up(bc, off); if (t >= off) bc += o; }
                const float av = gi - bc; float cm = av;
#pragma unroll
                for (int off = 1; off < 32; off <<= 1) { const float o = __shfl_up(cm, off); if (t >= off) cm = fmaxf(cm, o); }
                const float mt = bc + fmaxf(mprev, cm);
                const float bL = __shfl(bc, 31), mnew = __shfl(mt, 31);
                if (lane < 32) { sc[S_AS + t] = av; sc[S_BT + t] = bc - mt; sc[S_WINT + t] = expf(bc + mprev - mt); sc[S_EMT + t] = expf(-mt); sc[S_WLAST + t] = expf(bL + av - mnew); }
                if (lane == 0) { sc[S_DEC] = expf(bL + mprev - mnew); sc[S_M] = mnew; }
            }
            __syncthreads();
            if (w < 4) {
                const int si = w >> 1, ti = w & 1, tt = 16 * ti + li, sb = 16 * si + 4 * gq;
                u32x2 pw = (u32x2){0u, 0u}; float rs = 0.f;
                if (w != 2) {
                    f32x4 acc = (f32x4){0.f, 0.f, 0.f, 0.f};
#pragma unroll
                    for (int s = 0; s < 8; ++s) { const bf16x8 fa = *(const LAS bf16x8*)(lds + O_K + (16 * si + li) * QS + (32 * s + 8 * gq) * 2), fbq = *(const LAS bf16x8*)(lds + O_Q + tt * QS + (32 * s + 8 * gq) * 2);
                        acc = __builtin_amdgcn_mfma_f32_16x16x32_bf16(fa, fbq, acc, 0, 0, 0); }
                    const float btv = sc[S_BT + tt]; float v4[4];
#pragma unroll
                    for (int q = 0; q < 4; ++q) { v4[q] = (sb + q <= tt) ? acc[q] * __expf(btv + sc[S_AS + sb + q]) : 0.f; rs += v4[q]; }
                    pw.x = pkbf(v4[0], v4[1]); pw.y = pkbf(v4[2], v4[3]);
                }
                rs += __shfl_xor(rs, 16); rs += __shfl_xor(rs, 32);
                if (gq == 0) sc[S_DENP + si * 32 + tt] = rs;
                *(LAS u32x2*)(lds + O_ATT + tt * 80 + sb * 2) = pw;
            } else {
                const int tt = tid - 256;
                { const int v = tt & 127, tg = tt >> 7; unsigned short vr[16];
#pragma unroll
                  for (int j = 0; j < 16; ++j) vr[j] = lds_u16(lds + O_RV + (16 * tg + j) * 256 + 2 * v);
#pragma unroll
                  for (int i = 0; i < 2; ++i) { u32x4 wv; wv.x = vr[8 * i] | ((unsigned)vr[8 * i + 1] << 16); wv.y = vr[8 * i + 2] | ((unsigned)vr[8 * i + 3] << 16); wv.z = vr[8 * i + 4] | ((unsigned)vr[8 * i + 5] << 16); wv.w = vr[8 * i + 6] | ((unsigned)vr[8 * i + 7] << 16);
                      *(LAS u32x4*)(lds + O_VT + v * 80 + 32 * tg + 16 * i) = wv; } }
                { const int k = tt;
#pragma unroll
                  for (int i = 0; i < 4; ++i) { float kv[8];
#pragma unroll
                      for (int j = 0; j < 8; ++j) kv[j] = __uint_as_float((unsigned)lds_u16(lds + O_K + (8 * i + j) * QS + 2 * k) << 16) * sc[S_WLAST + 8 * i + j];
                      u32x4 wk; wk.x = pkbf(kv[0], kv[1]); wk.y = pkbf(kv[2], kv[3]); wk.z = pkbf(kv[4], kv[5]); wk.w = pkbf(kv[6], kv[7]);
                      *(LAS u32x4*)(lds + O_KWT + k * 80 + 16 * i) = wk; } }
                { const int t = tt >> 3, part = tt & 7; float s = 0.f;
#pragma unroll
                  for (int j = 0; j < 32; j += 2) { const unsigned qw = *(const LAS unsigned*)(lds + O_Q + t * QS + (32 * part + j) * 2); s += bf_lo(qw) * nv[32 * part + j] + bf_hi(qw) * nv[32 * part + j + 1]; }
                  s += __shfl_xor(s, 1); s += __shfl_xor(s, 2); s += __shfl_xor(s, 4);
                  if (part == 0) sc[S_QN + t] = s; }
            }
            __syncthreads();
            const int vj = w & 3;
            f32x16 accQ, accI;
#pragma unroll
            for (int j = 0; j < 16; ++j) { accQ[j] = 0.f; accI[j] = 0.f; }
#define ML_QC(Ct, i) do { const int ki = 4 * (w >> 2) + (i); _Pragma("unroll") for (int s = 0; s < 2; ++s) { \
                u32x4 xb; xb.x = pkbf(Ct[8 * s], Ct[8 * s + 1]); xb.y = pkbf(Ct[8 * s + 2], Ct[8 * s + 3]); xb.z = pkbf(Ct[8 * s + 4], Ct[8 * s + 5]); xb.w = pkbf(Ct[8 * s + 6], Ct[8 * s + 7]); \
                const u32x2 qa = *(const LAS u32x2*)(lds + O_Q + r * QS + (32 * ki + 16 * s + 4 * h) * 2), qb = *(const LAS u32x2*)(lds + O_Q + r * QS + (32 * ki + 16 * s + 4 * h + 8) * 2); \
                const u32x4 qf = (u32x4){qa.x, qa.y, qb.x, qb.y}; \
                accQ = __builtin_amdgcn_mfma_f32_32x32x16_bf16(__builtin_bit_cast(bf16x8, qf), __builtin_bit_cast(bf16x8, xb), accQ, 0, 0, 0); } } while (0)
            ML_QC(C0, 0); ML_QC(C1, 1); ML_QC(C2, 2); ML_QC(C3, 3);
#undef ML_QC
            bf16x8 fv[2];
#pragma unroll
            for (int s = 0; s < 2; ++s) fv[s] = *(const LAS bf16x8*)(lds + O_VT + (32 * vj + r) * 80 + (16 * s + 8 * h) * 2);
            if (w < 4) {
#pragma unroll
                for (int s = 0; s < 2; ++s) { const bf16x8 fa = *(const LAS bf16x8*)(lds + O_ATT + r * 80 + (16 * s + 8 * h) * 2); accI = __builtin_amdgcn_mfma_f32_32x32x16_bf16(fa, fv[s], accI, 0, 0, 0); }
            } else {
#pragma unroll
                for (int j = 0; j < 16; ++j) *(LAS float*)(lds + O_PQ + (w - 4) * 4096 + j * 256 + lane * 4) = accQ[j];
            }
            const float dec = sc[S_DEC];
#define ML_CU(Ct, i) do { const int ki = 4 * (w >> 2) + (i); _Pragma("unroll") for (int j = 0; j < 16; ++j) Ct[j] *= dec; _Pragma("unroll") for (int s = 0; s < 2; ++s) { \
                const bf16x8 fa = *(const LAS bf16x8*)(lds + O_KWT + (32 * ki + r) * 80 + (16 * s + 8 * h) * 2); Ct = __builtin_amdgcn_mfma_f32_32x32x16_bf16(fa, fv[s], Ct, 0, 0, 0); } } while (0)
            ML_CU(C0, 0); ML_CU(C1, 1); ML_CU(C2, 2); ML_CU(C3, 3);
#undef ML_CU
            if (tid < 256) { float s = 0.f;
#pragma unroll 8
                for (int t = 0; t < 32; ++t) s += sc[S_WLAST + t] * __uint_as_float((unsigned)lds_u16(lds + O_K + t * QS + 2 * tid) << 16);
                nv[tid] = dec * nv[tid] + s; }
            __syncthreads();
            if (w < 4) {
#pragma unroll
                for (int j = 0; j < 16; ++j) { const int t = (j & 3) + 8 * (j >> 2) + 4 * h;
                    const float wi = sc[S_WINT + t];
                    const float num = accI[j] + wi * (accQ[j] + *(const LAS float*)(lds + O_PQ + w * 4096 + j * 256 + lane * 4));
                    const float den = sc[S_DENP + t] + sc[S_DENP + 32 + t] + wi * sc[S_QN + t];
                    Hd[(size_t)scan_row(b, d, c * 32 + t) * D + head * 256 + vh * 128 + 32 * vj + r] = num / fmaxf(fabsf(den), sc[S_EMT + t]); }
            }
            if (c + 1 < NCH) ML_STORE();
            __syncthreads();
        }
#undef ML_LOAD
#undef ML_STORE
    }
}

struct Args { const float* in[31]; float* out; unsigned char* ws; int ph_lo, ph_hi; };
enum { I_X = 0, I_C, I_CTX, I_CCTX, I_MODW, I_MODB, I_LNG, I_LNB, I_F1W13, I_F1W2, I_F2W13, I_F2W2, I_HGWIN, I_HGLB, I_HGNG, I_HGWO, I_POOLW, I_POOLS,
       I_MLWIN, I_MLGB, I_MLNG, I_MLWO, I_S5LRE, I_S5LIM, I_S5LDT, I_S5BRE, I_S5BIM, I_S5CRE, I_S5CIM, I_S5D, I_S5GLU };

__global__ void __launch_bounds__(512, 2) mega(Args a) {
    extern __shared__ __attribute__((aligned(16))) unsigned char lds_raw[];
    LAS unsigned char* lds = (LAS unsigned char*)lds_raw;
    volatile LAS unsigned* MISC = (volatile LAS unsigned*)(lds + MISC_OFF);
    const int tid = threadIdx.x, lane = tid & 63, wave = __builtin_amdgcn_readfirstlane(tid >> 6);
    const int gw = blockIdx.x * 8 + wave, NGW = gridDim.x * 8;
    unsigned char* ws = a.ws;
    for (int u = tid; u < (LDS_BYTES - RING_BYTES) / 4; u += 512) ((LAS unsigned*)(lds + RING_BYTES))[u] = 0u;
    __syncthreads();
    XcdBarrier bar = xcd_barrier_post((unsigned*)(ws + WS_CTL) + CW_BAR, MISC + 8);
    const int lo = a.ph_lo, hi = a.ph_hi; int ph = 0;
#define PH_BEGIN if (ph >= lo && ph < hi) {
#define PH_END if (ph + 1 < hi) xcd_barrier(bar); } ++ph;

    float* MODV = (float*)(ws + WS_MODV); float* LB = (float*)(ws + WS_LB); float* S5A = (float*)(ws + WS_S5A); float* S5B = (float*)(ws + WS_S5B); float* GATES = (float*)(ws + WS_GATES);
    float* XZ = (float*)(ws + WS_XZ); bf16* H = (bf16*)(ws + WS_H); unsigned char* BIG = ws + WS_BIG;

    PH_BEGIN
    {
        LAS float* s_lds = (LAS float*)lds;
        LAS float* red = s_lds + 9 * D;
        for (int i = tid; i < 9 * D; i += 512) { const float x = i < 8 * D ? a.in[I_C][i] : a.in[I_CCTX][i - 8 * D]; s_lds[i] = fsilu(x); }
        __syncthreads();
        for (int item = blockIdx.x; item < DEPTH * (MODW / 64); item += gridDim.x) {
            const int l = item / (MODW / 64), n0 = (item % (MODW / 64)) * 64;
            const float* wp = a.in[I_MODW] + ((size_t)l * D + wave * 256) * MODW + n0 + lane;
            float acc[9];
#pragma unroll
            for (int j = 0; j < 9; ++j) acc[j] = 0.f;
#pragma unroll 4
            for (int k = 0; k < 256; k += 4) {
                const float w0 = wp[(size_t)k * MODW], w1 = wp[(size_t)(k + 1) * MODW], w2 = wp[(size_t)(k + 2) * MODW], w3 = wp[(size_t)(k + 3) * MODW];
#pragma unroll
                for (int j = 0; j < 9; ++j) { const f32x4 s4 = *(const LAS f32x4*)(s_lds + j * D + wave * 256 + k); acc[j] += (w0 * s4.x + w1 * s4.y) + (w2 * s4.z + w3 * s4.w); }
            }
#pragma unroll
            for (int j = 0; j < 9; ++j) red[(wave * 9 + j) * 64 + lane] = acc[j];
            __syncthreads();
            for (int o = tid; o < 9 * 64; o += 512) { const int j = o >> 6, ln = o & 63; float s = 0.f;
#pragma unroll
                for (int ww = 0; ww < 8; ++ww) s += red[(ww * 9 + j) * 64 + ln];
                MODV[((size_t)l * 9 + j) * MODW + n0 + ln] = s + a.in[I_MODB][(size_t)l * MODW + n0 + ln]; }
            __syncthreads();
        }
        for (int i = blockIdx.x * 512 + tid; i < 2 * D; i += gridDim.x * 512) { const int dd = i / D, c = i % D; const float* lp = a.in[I_HGLB] + (size_t)dd * DEPTH * D + c;
            float mx = lp[0]; for (int j = 1; j < DEPTH; ++j) mx = fmaxf(mx, lp[(size_t)j * D]); float sum = 0.f; for (int j = 0; j < DEPTH; ++j) sum += expf(lp[(size_t)j * D] - mx);
            LB[i] = expf(lp[0] - mx) / sum; }
        for (int i = blockIdx.x * 512 + tid; i < 2 * 128 * 64; i += gridDim.x * 512) { const int dg = i >> 6;
            const double lre = a.in[I_S5LRE][i], lim = a.in[I_S5LIM][i], dt = exp((double)a.in[I_S5LDT][dg]);
            const double mag = exp(lre * dt), abr = mag * cos(lim * dt), abi = mag * sin(lim * dt), den = lre * lre + lim * lim;
            const double nr = abr - 1.0, ni = abi, fr = (nr * lre + ni * lim) / den, fi = (ni * lre - nr * lim) / den;
            S5A[i] = (float)abr; S5A[2 * 128 * 64 + i] = (float)abi;
            for (int q = 0; q < 16; ++q) { const double br = a.in[I_S5BRE][(size_t)i * 16 + q], bi = a.in[I_S5BIM][(size_t)i * 16 + q];
                S5B[(size_t)i * 16 + q] = (float)(fr * br - fi * bi); S5B[(size_t)2 * 128 * 64 * 16 + (size_t)i * 16 + q] = (float)(fr * bi + fi * br); } }
        LAS float* scr = (LAS float*)(lds + wave * 16384);
        constexpr int I_HI = (D / 64) * (5 * D / 32), I_DD = (D / 64) * (D / 32), I_PW = (512 / 64) * (512 / 32), I_MI = (D / 64) * (8224 / 32), I_GL = (D / 64) * (2 * D / 32);
        for (int it = gw; it < I_HI + 2 * I_DD + 4 * I_PW + I_MI + I_GL; it += NGW) {
            int r = it;
            if (r < I_HI) { transpose_item(a.in[I_HGWIN], 5 * D, (bf16*)(ws + WS_HGIN), D, 0, 0, scr, r, lane); continue; } r -= I_HI;
            if (r < I_DD) { transpose_item(a.in[I_HGWO], D, (bf16*)(ws + WS_HGO), D, 0, 0, scr, r, lane); continue; } r -= I_DD;
            if (r < I_DD) { transpose_item(a.in[I_MLWO], D, (bf16*)(ws + WS_MLO), D, 0, 0, scr, r, lane); continue; } r -= I_DD;
            if (r < 4 * I_PW) { const int gq = r / I_PW; transpose_item(a.in[I_POOLW] + (size_t)gq * 512 * 512, 512, (bf16*)(ws + WS_POOLW) + (size_t)gq * 512 * 512, 512, 0, 0, scr, r % I_PW, lane); continue; } r -= 4 * I_PW;
            if (r < I_MI) { transpose_item(a.in[I_MLWIN], 8224, (bf16*)(ws + WS_MLIN), D, 0, 0, scr, r, lane); continue; } r -= I_MI;
            transpose_item(a.in[I_S5GLU], 2 * D, (bf16*)(ws + WS_GLU), D, 1, D, scr, r, lane);
        }
        for (int i = blockIdx.x * 512 + tid; i < (MLN - 8224) * D / 8; i += gridDim.x * 512) ((u32x4*)((bf16*)(ws + WS_MLIN) + (size_t)8224 * D))[i] = (u32x4){0u, 0u, 0u, 0u};
        convert_ffn_layer(a.in[I_F1W13], a.in[I_F1W2], a.in[I_F2W13], a.in[I_F2W2], ws, scr, gw, NGW, lane);
    }
    PH_END

    PH_BEGIN
    row_phase<0>(gw, NGW, lane, R, a.in[I_X], a.in[I_CTX], XZ, H, nullptr, nullptr, MODV, 0, 1, nullptr);
    PH_END

#define LAYER_BODY(l) { \
        const float* modl = MODV + (size_t)l * 9 * MODW; \
        const float* lng = a.in[I_LNG] + (size_t)l * 3 * D; const float* lnb = a.in[I_LNB] + (size_t)l * 3 * D; \
        PH_BEGIN { pg8::Gemm g{H, (const bf16*)(ws + WS_W13A), R, 2 * FF, D, D, D, 0}; EpiSwiglu E{(bf16*)BIG}; pg8::gemm_phase(lds, g, E); if (PROBE_DUP & 2) pg8::gemm_phase(lds, g, E); } PH_END \
        PH_BEGIN { pg8::Gemm g{(const bf16*)BIG, (const bf16*)(ws + WS_W2A), R, D, FF, FF, FF, 0}; EpiResid E{XZ, modl, 2, 0.5f, nullptr}; pg8::gemm_phase(lds, g, E); } PH_END \
        PH_BEGIN row_phase<1>(gw, NGW, lane, R, nullptr, nullptr, XZ, H, lng, lnb, modl, 3, 4, nullptr); PH_END \
        const int MR = (l == DEPTH - 1) ? RL : R; \
        if (l == 0) { \
            PH_BEGIN { pg8::Gemm g{H, (const bf16*)(ws + WS_HGIN), R, 5 * D, D, D, D, 0}; EpiHgIn E{(bf16*)BIG, LB}; pg8::gemm_phase(lds, g, E); } PH_END \
            PH_BEGIN hgrn_scan_mfma(lds, (const bf16*)BIG, (float*)(BIG + BIG_O1_HG), (float*)(BIG + BIG_O2_HG), tid); if (PROBE_DUP & 1) { __syncthreads(); hgrn_scan_mfma(lds, (const bf16*)BIG, (float*)(BIG + BIG_O1_HG), (float*)(BIG + BIG_O2_HG), tid); } PH_END \
            PH_BEGIN readout_phase<128>(gw, NGW, lane, (const float*)(BIG + BIG_O1_HG), (const float*)(BIG + BIG_O2_HG), (const bf16*)BIG, 5 * D, 2 * D, a.in[I_HGNG], H); PH_END \
            PH_BEGIN { pg8::Gemm g{H, (const bf16*)(ws + WS_HGO), MR, D, D, D, D, 0}; EpiResid E{XZ, modl, 5, 1.0f, nullptr}; pg8::gemm_phase(lds, g, E); } PH_END \
        } \
        if (l == 1) { \
            PH_BEGIN pool_phase(gw, NGW, lane, XZ, H, modl, 4); PH_END \
            PH_BEGIN { pg8::Gemm g{H, (const bf16*)(ws + WS_POOLW), MR, D, 512, D, 512, 2}; EpiResid E{XZ, modl, 5, 1.0f, a.in[I_POOLS]}; pg8::gemm_phase(lds, g, E); } PH_END \
        } \
        if (l == 2) { \
            PH_BEGIN { pg8::Gemm g{H, (const bf16*)(ws + WS_MLIN), R, MLN, D, D, D, 0}; EpiMlIn E{(bf16*)BIG, GATES, a.in[I_MLGB]}; pg8::gemm_phase(lds, g, E); } PH_END \
            PH_BEGIN mlstm_scan_mfma(lds, (const bf16*)BIG, GATES, (float*)(BIG + BIG_O1_ML), (float*)(BIG + BIG_O2_ML), tid); if (PROBE_DUP & 1) { __syncthreads(); mlstm_scan_mfma(lds, (const bf16*)BIG, GATES, (float*)(BIG + BIG_O1_ML), (float*)(BIG + BIG_O2_ML), tid); } PH_END \
            PH_BEGIN readout_phase<256>(gw, NGW, lane, (const float*)(BIG + BIG_O1_ML), (const float*)(BIG + BIG_O2_ML), (const bf16*)BIG, 4 * D, 3 * D, a.in[I_MLNG], H); PH_END \
            PH_BEGIN { pg8::Gemm g{H, (const bf16*)(ws + WS_MLO), MR, D, D, D, D, 0}; EpiResid E{XZ, modl, 5, 1.0f, nullptr}; pg8::gemm_phase(lds, g, E); } PH_END \
        } \
        if (l == 3) { \
            PH_BEGIN s5_scan_mfma(lds, H, S5A, S5B, a.in[I_S5CRE], a.in[I_S5CIM], (float*)(BIG + BIG_O1_S5), (float*)(BIG + BIG_O2_S5), tid); if (PROBE_DUP & 1) { __syncthreads(); s5_scan_mfma(lds, H, S5A, S5B, a.in[I_S5CRE], a.in[I_S5CIM], (float*)(BIG + BIG_O1_S5), (float*)(BIG + BIG_O2_S5), tid); } PH_END \
            PH_BEGIN s5_readout_phase(gw, NGW, lane, (const float*)(BIG + BIG_O1_S5), (const float*)(BIG + BIG_O2_S5), XZ, a.in[I_S5D], modl, 3, 4, H); PH_END \
            PH_BEGIN { pg8::Gemm g{H, (const bf16*)(ws + WS_GLU), MR, 2 * D, D, D, D, 0}; EpiS5Glu E{XZ, modl, 5}; pg8::gemm_phase(lds, g, E); } PH_END \
        } \
        PH_BEGIN row_phase<1>(gw, NGW, lane, MR, nullptr, nullptr, XZ, H, lng + D, lnb + D, modl, 6, 7, nullptr); PH_END \
        PH_BEGIN { pg8::Gemm g{H, (const bf16*)(ws + WS_W13B), MR, 2 * FF, D, D, D, 0}; EpiSwiglu E{(bf16*)BIG}; pg8::gemm_phase(lds, g, E); if (PROBE_DUP & 2) pg8::gemm_phase(lds, g, E); } PH_END \
        PH_BEGIN { pg8::Gemm g{(const bf16*)BIG, (const bf16*)(ws + WS_W2B), MR, D, FF, FF, FF, 0}; EpiResid E{XZ, modl, 8, 0.5f, nullptr}; pg8::gemm_phase(lds, g, E); } PH_END \
        PH_BEGIN \
        if (l + 1 < DEPTH) { \
            row_phase<1>(gw, NGW, lane, R, nullptr, nullptr, XZ, H, lng + 2 * D, lnb + 2 * D, modl + (size_t)9 * MODW, 0, 1, nullptr); \
            const size_t o13 = (size_t)(l + 1) * D * 2 * FF, o2 = (size_t)(l + 1) * FF * D; \
            convert_ffn_layer(a.in[I_F1W13] + o13, a.in[I_F1W2] + o2, a.in[I_F2W13] + o13, a.in[I_F2W2] + o2, ws, (LAS float*)(lds + wave * 16384), gw, NGW, lane); \
        } else { \
            row_phase<1>(gw, NGW, lane, RL, nullptr, nullptr, XZ, nullptr, lng + 2 * D, lnb + 2 * D, modl, 0, 1, a.out); \
        } \
        PH_END \
    }
    LAYER_BODY(0) LAYER_BODY(1) LAYER_BODY(2) LAYER_BODY(3)
#undef LAYER_BODY
#undef PH_BEGIN
#undef PH_END
}

static int n_phases() { int n = 2; for (int l = 0; l < DEPTH; ++l) { n += 3; n += (l == 0 || l == 2) ? 4 : (l == 1 ? 2 : 3); n += 1 + 3; } return n; }

extern "C" void kernel_launch(void* const* d_in, const int* in_sizes, int n_in, void* d_out, int out_size, void* d_ws, size_t ws_size, hipStream_t stream) {
    static int grid = 0;
    if (grid == 0) {
        if (n_in != 31 || in_sizes[0] != RL * D || out_size != RL * D || ws_size < WS_END) {
            fprintf(stderr, "kernel_launch: unexpected problem: n_in %d in0 %d out %d ws %zu (need %zu)\n", n_in, n_in > 0 ? in_sizes[0] : -1, out_size, ws_size, (size_t)WS_END); grid = -1; return; }
        int dev = 0, cus = 0, per_cu = 0;
        if (hipGetDevice(&dev) != hipSuccess || hipDeviceGetAttribute(&cus, hipDeviceAttributeMultiprocessorCount, dev) != hipSuccess) { grid = -1; return; }
        if (hipFuncSetAttribute((const void*)mega, hipFuncAttributeMaxDynamicSharedMemorySize, LDS_BYTES) != hipSuccess) { fprintf(stderr, "kernel_launch: hipFuncSetAttribute failed\n"); grid = -1; return; }
        if (hipOccupancyMaxActiveBlocksPerMultiprocessor(&per_cu, (const void*)mega, 512, LDS_BYTES) != hipSuccess || per_cu < 1) fprintf(stderr, "kernel_launch: occupancy query reports %d\n", per_cu);
        (void)hipGetLastError();
        grid = cus;
    }
    if (grid < 0) return;
    (void)hipMemsetAsync((char*)d_ws + WS_CTL, 0, CTL_BYTES, stream);
    Args a{};
    for (int i = 0; i < 31; ++i) a.in[i] = (const float*)d_in[i];
    a.out = (float*)d_out; a.ws = (unsigned char*)d_ws;
    const int NPH = n_phases();
#if MK_MULTI
    for (int p = 0; p < NPH; ++p) { a.ph_lo = p; a.ph_hi = p + 1; hipLaunchKernelGGL(mega, dim3(grid), dim3(512), LDS_BYTES, stream, a); }
#else
    a.ph_lo = 0; a.ph_hi = NPH; hipLaunchKernelGGL(mega, dim3(grid), dim3(512), LDS_BYTES, stream, a);
#endif
}
```
